# Optimizing an MI355X kernel written in HIP

```python
import numpy as np
import jax, jax.numpy as jnp
from jax import lax

D_MODEL = 1024
BATCH = 2
SEQ = 8192
DEPTH = 1

CONV_CH = 512
CONV_GROUPS = 8
CONV_K = 3
N_HEADS = 8
N_KV_GROUPS = 2
HEADS_PER_GROUP = N_HEADS // N_KV_GROUPS
HEAD_DIM = 64
ATTN_WIDTH = N_HEADS * HEAD_DIM
KV_WIDTH = N_KV_GROUPS * HEAD_DIM
MIX_WIDTH = CONV_CH + ATTN_WIDTH
ROPE_THETA = 500000.0
ROT_DIM = HEAD_DIM // 4
CMP_BLOCK = 32
CMP_STRIDE = 16
CMP_HIDDEN = 256
SLC_BLOCK = 64
SLC_TOP_N = 16
WINDOW = 512
Q_BLOCK = 128
D_FF = 2816
MACARON_W = 0.5
N_MOD = 9
IN_WIDTH = 3 * CONV_CH + ATTN_WIDTH + 6 * KV_WIDTH + 3 * N_HEADS
EPS = 1e-6
NEG = -1e30
BIG = 1e9

kernel_name = "hymba_conv_nsa_macaron_adaln"


def _rmsnorm(x, g):
    xf = x.astype(jnp.float32)
    y = xf * lax.rsqrt(jnp.mean(xf * xf, axis=-1, keepdims=True) + EPS)
    return (y * g.astype(jnp.float32)).astype(x.dtype)


def _group_rmsnorm(y, g, n_groups):
    shp = y.shape
    yg = y.reshape(shp[:-1] + (n_groups, shp[-1] // n_groups)).astype(jnp.float32)
    yg = yg * lax.rsqrt(jnp.mean(yg * yg, axis=-1, keepdims=True) + EPS)
    return (yg.reshape(shp) * g.astype(jnp.float32)).astype(y.dtype)


def _modulate(h, shift, scale):
    return h * (1.0 + scale) + shift


def _swiglu(h, w_gate, w_up, w_down):
    return (jax.nn.silu(h @ w_gate) * (h @ w_up)) @ w_down


def _partial_rope(t, positions):
    half = ROT_DIM // 2
    freqs = jnp.power(ROPE_THETA, -2.0 * jnp.arange(half, dtype=jnp.float32) / ROT_DIM)
    ang = positions.astype(jnp.float32)[:, :, None] * freqs
    cos = jnp.cos(ang)[:, :, None, :].astype(t.dtype)
    sin = jnp.sin(ang)[:, :, None, :].astype(t.dtype)
    t1, t2, rest = t[..., :half], t[..., half:ROT_DIM], t[..., ROT_DIM:]
    return jnp.concatenate([t1 * cos - t2 * sin, t2 * cos + t1 * sin, rest], axis=-1)


def _compress(k, pos_emb, w1, w2):
    S = k.shape[2]
    n_cmp = (S - CMP_BLOCK) // CMP_STRIDE + 1
    idx = np.arange(n_cmp)[:, None] * CMP_STRIDE + np.arange(CMP_BLOCK)[None, :]
    blocks = k[:, :, idx] + pos_emb
    flat = blocks.reshape(k.shape[0], k.shape[1], n_cmp, CMP_BLOCK * k.shape[3])
    return jax.nn.silu(flat @ w1) @ w2


def _cmp_slc_overlap(n_cmp, n_slc):
    c0 = np.arange(n_cmp) * CMP_STRIDE
    c1 = c0 + CMP_BLOCK - 1
    s0 = np.arange(n_slc) * SLC_BLOCK
    s1 = s0 + SLC_BLOCK - 1
    return ((c0[:, None] <= s1[None, :]) & (c1[:, None] >= s0[None, :])).astype(np.float32)


def _masked_softmax(s, mask):
    return jax.nn.softmax(jnp.where(mask, s, NEG), axis=-1)


def _nsa_attention(q, kc, vc, ks, vs, kw, vw, gates):
    B, G, HPG, S, dk = q.shape
    n_cmp = kc.shape[2]
    n_slc = S // SLC_BLOCK
    top_n = min(SLC_TOP_N, n_slc)
    scale = dk ** -0.5
    cmp_end = jnp.arange(n_cmp) * CMP_STRIDE + CMP_BLOCK - 1
    overlap = jnp.asarray(_cmp_slc_overlap(n_cmp, n_slc))
    ks_blk = ks.reshape(B, G, n_slc, SLC_BLOCK, dk)
    vs_blk = vs.reshape(B, G, n_slc, SLC_BLOCK, dk)
    kw_pad = jnp.pad(kw, ((0, 0), (0, 0), (WINDOW, 0), (0, 0)))
    vw_pad = jnp.pad(vw, ((0, 0), (0, 0), (WINDOW, 0), (0, 0)))
    b_idx = jnp.arange(B)[:, None, None, None]
    g_idx = jnp.arange(G)[None, :, None, None]
    blk = jnp.arange(n_slc)
    in_blk = jnp.arange(SLC_BLOCK)
    win_off = jnp.arange(WINDOW + Q_BLOCK) - WINDOW

    def one_block(qb):
        t0 = qb * Q_BLOCK
        t = t0 + jnp.arange(Q_BLOCK)
        qblk = lax.dynamic_slice_in_dim(q, t0, Q_BLOCK, axis=3)
        gblk = jax.nn.sigmoid(lax.dynamic_slice_in_dim(gates, t0, Q_BLOCK, axis=3).astype(jnp.float32))

        s = jnp.einsum('bghqd,bgnd->bghqn', qblk, kc).astype(jnp.float32) * scale
        valid = cmp_end[None, :] <= t[:, None]
        p_cmp = _masked_softmax(s, valid) * valid
        o_cmp = jnp.einsum('bghqn,bgnd->bghqd', p_cmp.astype(vc.dtype), vc)

        imp = jnp.einsum('bghqn,nj->bgqj', p_cmp, overlap)
        cur = t // SLC_BLOCK
        future = blk[None, :] > cur[:, None]
        forced = (blk[None, :] == 0) | (blk[None, :] == cur[:, None]) | (blk[None, :] == cur[:, None] - 1)
        score = jnp.where(future, -BIG, jnp.where(forced, BIG, imp))
        _, idx = lax.top_k(score, top_n)
        k_sel = ks_blk[b_idx, g_idx, idx].reshape(B, G, Q_BLOCK, top_n * SLC_BLOCK, dk)
        v_sel = vs_blk[b_idx, g_idx, idx].reshape(B, G, Q_BLOCK, top_n * SLC_BLOCK, dk)
        pos_sel = (idx[..., None] * SLC_BLOCK + in_blk).reshape(B, G, Q_BLOCK, top_n * SLC_BLOCK)
        mask_sel = (pos_sel <= t[None, None, :, None])[:, :, None]
        s = jnp.einsum('bghqd,bgqkd->bghqk', qblk, k_sel).astype(jnp.float32) * scale
        p = _masked_softmax(s, mask_sel)
        o_slc = jnp.einsum('bghqk,bgqkd->bghqd', p.astype(v_sel.dtype), v_sel)

        k_win = lax.dynamic_slice_in_dim(kw_pad, t0, WINDOW + Q_BLOCK, axis=2)
        v_win = lax.dynamic_slice_in_dim(vw_pad, t0, WINDOW + Q_BLOCK, axis=2)
        pos_win = t0 + win_off
        dist = t[:, None] - pos_win[None, :]
        mask_win = (pos_win[None, :] >= 0) & (dist >= 0) & (dist < WINDOW)
        s = jnp.einsum('bghqd,bgkd->bghqk', qblk, k_win).astype(jnp.float32) * scale
        p = _masked_softmax(s, mask_win)
        o_win = jnp.einsum('bghqk,bgkd->bghqd', p.astype(v_win.dtype), v_win)

        o = gblk[..., 0:1] * o_cmp + gblk[..., 1:2] * o_slc + gblk[..., 2:3] * o_win
        return o.astype(q.dtype)

    out = lax.map(one_block, jnp.arange(S // Q_BLOCK))
    return out.transpose(1, 0, 4, 2, 3, 5).reshape(B, S, G * HPG * dk)


def _hybrid_mixer(h, positions, w_in, conv_w, cmp_pos_k, cmp_pos_v, w_cmpk1, w_cmpk2,
                  w_cmpv1, w_cmpv2, g_out_conv, g_out_attn, w_out):
    B, S, _ = h.shape
    proj = h @ w_in
    sizes = [CONV_CH, CONV_CH, CONV_CH, ATTN_WIDTH] + [KV_WIDTH] * 6 + [3 * N_HEADS]
    cuts = np.cumsum(sizes)[:-1].tolist()
    cb, cc, cx, q, kc, vc, ks, vs, kw, vw, gt = jnp.split(proj, cuts, axis=-1)

    u = cc * cx
    v = lax.conv_general_dilated(u, conv_w[:, None, :], window_strides=(1,),
                                 padding=[(CONV_K - 1, 0)],
                                 dimension_numbers=('NWC', 'WIO', 'NWC'),
                                 feature_group_count=CONV_CH)
    y_conv = cb * v

    qh = _partial_rope(q.reshape(B, S, N_HEADS, HEAD_DIM), positions)
    qh = qh.reshape(B, S, N_KV_GROUPS, HEADS_PER_GROUP, HEAD_DIM).transpose(0, 2, 3, 1, 4)

    def kv_heads(t, rope):
        t = t.reshape(B, S, N_KV_GROUPS, HEAD_DIM)
        if rope:
            t = _partial_rope(t, positions)
        return t.transpose(0, 2, 1, 3)

    kc_c = _compress(kv_heads(kc, True), cmp_pos_k, w_cmpk1, w_cmpk2)
    vc_c = _compress(kv_heads(vc, False), cmp_pos_v, w_cmpv1, w_cmpv2)
    gates = gt.reshape(B, S, N_KV_GROUPS, HEADS_PER_GROUP, 3).transpose(0, 2, 3, 1, 4)
    y_attn = _nsa_attention(qh, kc_c, vc_c, kv_heads(ks, True), kv_heads(vs, False),
                            kv_heads(kw, True), kv_heads(vw, False), gates)

    y = jnp.concatenate([_group_rmsnorm(y_conv, g_out_conv, CONV_GROUPS),
                         _group_rmsnorm(y_attn, g_out_attn, N_HEADS)], axis=-1)
    return y @ w_out


def setup_inputs(seed: int = 0) -> dict:
    key = jax.random.key(seed)
    ks = jax.random.split(key, 32)
    f32 = jnp.float32

    def nrm(k, shape, s):
        return jax.random.normal(k, shape, f32) * s

    def gain(k, shape):
        return 1.0 + 0.02 * jax.random.normal(k, shape, f32)

    L, D = DEPTH, D_MODEL
    return {
        "x": nrm(ks[0], (BATCH, SEQ, D), 1.0),
        "c": nrm(ks[1], (BATCH, D), 1.0),
        "positions": jnp.tile(jnp.arange(SEQ, dtype=jnp.int32)[None, :], (BATCH, 1)),
        "w_ada": nrm(ks[2], (L, D, N_MOD * D), 0.5 * D ** -0.5),
        "b_ada": nrm(ks[3], (L, N_MOD * D), 0.1),
        "g_ffn1": gain(ks[4], (L, D)),
        "w1_gate": nrm(ks[5], (L, D, D_FF), D ** -0.5),
        "w1_up": nrm(ks[6], (L, D, D_FF), D ** -0.5),
        "w1_down": nrm(ks[7], (L, D_FF, D), D_FF ** -0.5),
        "g_mix": gain(ks[8], (L, D)),
        "w_in": nrm(ks[9], (L, D, IN_WIDTH), D ** -0.5),
        "conv_w": nrm(ks[10], (L, CONV_K, CONV_CH), CONV_K ** -0.5),
        "cmp_pos_k": nrm(ks[11], (L, CMP_BLOCK, HEAD_DIM), 0.5),
        "cmp_pos_v": nrm(ks[12], (L, CMP_BLOCK, HEAD_DIM), 0.5),
        "w_cmpk1": nrm(ks[13], (L, CMP_BLOCK * HEAD_DIM, CMP_HIDDEN), (CMP_BLOCK * HEAD_DIM) ** -0.5),
        "w_cmpk2": nrm(ks[14], (L, CMP_HIDDEN, HEAD_DIM), CMP_HIDDEN ** -0.5),
        "w_cmpv1": nrm(ks[15], (L, CMP_BLOCK * HEAD_DIM, CMP_HIDDEN), (CMP_BLOCK * HEAD_DIM) ** -0.5),
        "w_cmpv2": nrm(ks[16], (L, CMP_HIDDEN, HEAD_DIM), CMP_HIDDEN ** -0.5),
        "g_out_conv": gain(ks[17], (L, CONV_CH)),
        "g_out_attn": gain(ks[18], (L, ATTN_WIDTH)),
        "w_out": nrm(ks[19], (L, MIX_WIDTH, D), MIX_WIDTH ** -0.5),
        "g_ffn2": gain(ks[20], (L, D)),
        "w2_gate": nrm(ks[21], (L, D, D_FF), D ** -0.5),
        "w2_up": nrm(ks[22], (L, D, D_FF), D ** -0.5),
        "w2_down": nrm(ks[23], (L, D_FF, D), D_FF ** -0.5),
        "g_final": gain(ks[24], (D,)),
    }


def reference(x, c, positions, w_ada, b_ada, g_ffn1, w1_gate, w1_up, w1_down, g_mix, w_in,
              conv_w, cmp_pos_k, cmp_pos_v, w_cmpk1, w_cmpk2, w_cmpv1, w_cmpv2, g_out_conv,
              g_out_attn, w_out, g_ffn2, w2_gate, w2_up, w2_down, g_final):
    B = x.shape[0]
    c_act = jax.nn.silu(c)
    for l in range(DEPTH):
        mod = (c_act @ w_ada[l] + b_ada[l]).reshape(B, N_MOD, D_MODEL)[:, :, None, :]
        sh1, sc1, gt1, sh2, sc2, gt2, sh3, sc3, gt3 = [mod[:, i] for i in range(N_MOD)]
        h = _modulate(_rmsnorm(x, g_ffn1[l]), sh1, sc1)
        x = x + MACARON_W * gt1 * _swiglu(h, w1_gate[l], w1_up[l], w1_down[l])
        h = _modulate(_rmsnorm(x, g_mix[l]), sh2, sc2)
        x = x + gt2 * _hybrid_mixer(h, positions, w_in[l], conv_w[l], cmp_pos_k[l], cmp_pos_v[l],
                                    w_cmpk1[l], w_cmpk2[l], w_cmpv1[l], w_cmpv2[l],
                                    g_out_conv[l], g_out_attn[l], w_out[l])
        h = _modulate(_rmsnorm(x, g_ffn2[l]), sh3, sc3)
        x = x + MACARON_W * gt3 * _swiglu(h, w2_gate[l], w2_up[l], w2_down[l])
    return _rmsnorm(x, g_final)
```

```cpp
#include <hip/hip_runtime.h>
#include <hip/hip_cooperative_groups.h>
#include <cstdio>
#include <cstdint>
namespace cg = cooperative_groups;

typedef unsigned short bf16_t;
typedef float f32x4 __attribute__((ext_vector_type(4)));
typedef unsigned u32x4 __attribute__((ext_vector_type(4)));
typedef unsigned u32x2 __attribute__((ext_vector_type(2)));

constexpr int NB = 2, SEQ = 8192, DM = 1024, T = NB * SEQ, DFF = 2816, INW = 2840, PJ = 3072;
constexpr int NMODC = 9 * DM;
constexpr float EPS = 1e-6f;
constexpr float QSCALE = 0.125f * 1.4426950408889634f;
constexpr int NTHR = 512, NWV = 8;
constexpr int LDS_BYTES = 147456;
constexpr float NEGV = -1e30f, BIGV = 1e9f;
constexpr int C_CB = 0, C_CC = 512, C_CX = 1024, C_Q = 1536, C_KV = 2048, C_GT = 2816;

constexpr size_t MiB = 1u << 20;
constexpr size_t WS_MODP = 0, WS_MOD = 2 * MiB, WS_B1P = 3 * MiB  , WS_BAR = 3 * MiB + 262144  , WS_XN = 4 * MiB, WS_Y = 36 * MiB, WS_BIG = 68 * MiB, WS_Q = 164 * MiB,
                 WS_KV = 180 * MiB  , WS_KCC = 204 * MiB, WS_VCC = 205 * MiB,
                 WS_W1GU = 206 * MiB, WS_W1D = 217 * MiB, WS_W2GU = 223 * MiB, WS_W2D = 234 * MiB, WS_WIN = 240 * MiB, WS_WOUT = 246 * MiB,
                 WS_WC1K = 248 * MiB, WS_WC1V = 249 * MiB, WS_WC2K = 250 * MiB, WS_WC2V = 250 * MiB + 65536, WS_RSS = 251 * MiB  , WS_BIAS = 252 * MiB  , WS_END = 253 * MiB;

struct Params {
    const float* x; const float* c; const int* pos; const float* w_ada; const float* b_ada; const float* g_ffn1;
    const float* w1g; const float* w1u; const float* w1d; const float* g_mix; const float* w_in; const float* conv_w;
    const float* cpk; const float* cpv; const float* wck1; const float* wck2; const float* wcv1; const float* wcv2;
    const float* goc; const float* goa; const float* w_out; const float* g_ffn2; const float* w2g; const float* w2u;
    const float* w2d; const float* g_final;
    float* out; unsigned char* ws;
};

__device__ __forceinline__ unsigned f2bf(float f) { unsigned u = __float_as_uint(f); return (u + 0x7fffu + ((u >> 16) & 1u)) >> 16; }
__device__ __forceinline__ float bf2f(unsigned v) { return __uint_as_float(v << 16); }
__device__ __forceinline__ unsigned pk2(float lo, float hi) { return f2bf(lo) | (f2bf(hi) << 16); }
__device__ __forceinline__ void ld8(const bf16_t* p, float (&v)[8]) {
    const u32x4 w = *(const u32x4*)p;
    v[0] = bf2f(w.x & 0xffffu); v[1] = bf2f(w.x >> 16); v[2] = bf2f(w.y & 0xffffu); v[3] = bf2f(w.y >> 16);
    v[4] = bf2f(w.z & 0xffffu); v[5] = bf2f(w.z >> 16); v[6] = bf2f(w.w & 0xffffu); v[7] = bf2f(w.w >> 16);
}
__device__ __forceinline__ void st8(bf16_t* p, const float (&v)[8]) {
    u32x4 w; w.x = pk2(v[0], v[1]); w.y = pk2(v[2], v[3]); w.z = pk2(v[4], v[5]); w.w = pk2(v[6], v[7]);
    *(u32x4*)p = w;
}
__device__ __forceinline__ float wave_sum(float v) {
#pragma unroll
    for (int o = 1; o < 64; o <<= 1) v += __shfl_xor(v, o);
    return v;
}
__device__ __forceinline__ float wave_max(float v) {
#pragma unroll
    for (int o = 1; o < 64; o <<= 1) v = fmaxf(v, __shfl_xor(v, o));
    return v;
}
__device__ __forceinline__ float silu_f(float v) { return v / (1.0f + expf(-v)); }
__device__ __forceinline__ unsigned xcc_id_hw() { return (unsigned)__builtin_amdgcn_s_getreg((3 << 11) | 20) & 0xFu; }
#define WSYNC() do { asm volatile("s_waitcnt lgkmcnt(0)" ::: "memory"); __builtin_amdgcn_wave_barrier(); } while (0)

namespace pg8 {
#define PG8_LAS __attribute__((address_space(3)))
typedef unsigned short bf16_t;
typedef short bf16x8 __attribute__((ext_vector_type(8)));
typedef float f32x4 __attribute__((ext_vector_type(4)));
typedef unsigned u32x4 __attribute__((ext_vector_type(4)));
constexpr int BM = 256, BK = 64, HALF = 128, HTB = HALF * BK * 2  , STAGE_BYTES = 8 * HTB, NXCD = 8, WGM = 8;

__host__ __device__ __forceinline__ int lds_byte(int r, int c) { const int st = (r >> 4) * 2 + (c >> 5), rr = r & 15, cc = c & 31, ob = rr * 64 + cc * 2; return st * 1024 + (ob ^ (((ob >> 9) & 1) << 5)); }
__host__ __device__ __forceinline__ void stage_rc(int b, int& R, int& C) { const int st = b / 1024, sb = b % 1024, swz = sb ^ (((sb >> 9) & 1) << 5); R = (st >> 1) * 16 + swz / 64; C = (st & 1) * 32 + (swz % 64) / 2; }
__host__ __device__ __forceinline__ int perm32(int rho) { const int n = rho >> 4, i = rho & 15; return 8 * (i >> 2) + 4 * n + (i & 3); }

struct Unit { int pm, pn; };
struct Gemm { const bf16_t* A; const bf16_t* Bt; int M, N, K; };

struct StaticOrder {
    int nM, nN, nwg, G, c;
    __host__ __device__ void init(int M, int N, int G_, int c_) { nM = M / BM; nN = N / BM; nwg = nM * nN; G = G_; c = c_; }
    __host__ __device__ bool next(int i, Unit& u) const {
        const long L = (long)i * G + c; if (L >= nwg) return false;
        int wgid = (int)L; { const int q = nwg / NXCD, r = nwg % NXCD, xcd = wgid % NXCD, off = wgid / NXCD; wgid = (xcd < r ? xcd * (q + 1) : r * (q + 1) + (xcd - r) * q) + off; }
        const int nig = WGM * nN, gid = wgid / nig, fm = gid * WGM, gsz = (nM - fm) < WGM ? (nM - fm) : WGM;
        u.pm = fm + ((wgid % nig) % gsz); u.pn = (wgid % nig) / gsz; return true;
    }
    __device__ __forceinline__ void a_ready(const Unit&) const {}
    __device__ __forceinline__ void done(const Unit&) const {}
};

__device__ __forceinline__ unsigned cvt_pk_bf16(float lo, float hi) { unsigned r; asm volatile("v_cvt_pk_bf16_f32 %0, %1, %2" : "=v"(r) : "v"(lo), "v"(hi)); return r; }
typedef float f32x2 __attribute__((ext_vector_type(2)));

__device__ __forceinline__ float silu_fast(float v) { return v * __builtin_amdgcn_rcpf(1.0f + __expf(-v)); }
struct EpiBf16 {
    static constexpr bool PERM = true, AFTER_DRAIN = false;
    bf16_t* O; int ldc;
    __device__ __forceinline__ void operator()(const f32x4 (&acc)[2][2][4][2], const Unit& u, int wr, int wc, int fr, int fq) const {
        const int row0 = u.pm * BM + wr * 64 + fr, col0 = u.pn * BM + wc * 32 + 8 * fq;
#pragma unroll
        for (int ai = 0; ai < 2; ++ai)
#pragma unroll
            for (int m = 0; m < 4; ++m) { bf16_t* rowp = O + (size_t)(row0 + ai * HALF + m * 16) * ldc + col0;
#pragma unroll
                for (int bj = 0; bj < 2; ++bj) { const f32x4 v0 = acc[ai][bj][m][0], v1 = acc[ai][bj][m][1];
                    u32x4 w; w.x = cvt_pk_bf16(v0[0], v0[1]); w.y = cvt_pk_bf16(v0[2], v0[3]); w.z = cvt_pk_bf16(v1[0], v1[1]); w.w = cvt_pk_bf16(v1[2], v1[3]);
                    *(u32x4*)(rowp + bj * HALF) = w; } }
    }
};
struct EpiSwiglu {
    static constexpr bool PERM = true, AFTER_DRAIN = false;
    bf16_t* O; int ldc;
    __device__ __forceinline__ void operator()(const f32x4 (&acc)[2][2][4][2], const Unit& u, int wr, int wc, int fr, int fq) const {
        const int row0 = u.pm * BM + wr * 64 + fr, col0 = u.pn * HALF + wc * 32 + 8 * fq;
#pragma unroll
        for (int ai = 0; ai < 2; ++ai)
#pragma unroll
            for (int m = 0; m < 4; ++m) { bf16_t* rowp = O + (size_t)(row0 + ai * HALF + m * 16) * ldc + col0;
                const f32x4 g0 = acc[ai][0][m][0], g1 = acc[ai][0][m][1], u0 = acc[ai][1][m][0], u1 = acc[ai][1][m][1];
                u32x4 w;
                w.x = cvt_pk_bf16(silu_fast(g0[0]) * u0[0], silu_fast(g0[1]) * u0[1]); w.y = cvt_pk_bf16(silu_fast(g0[2]) * u0[2], silu_fast(g0[3]) * u0[3]);
                w.z = cvt_pk_bf16(silu_fast(g1[0]) * u1[0], silu_fast(g1[1]) * u1[1]); w.w = cvt_pk_bf16(silu_fast(g1[2]) * u1[2], silu_fast(g1[3]) * u1[3]);
                *(u32x4*)rowp = w; }
    }
};
struct EpiResid {
    static constexpr bool PERM = false, AFTER_DRAIN = false;
    const float* base; float* out; const float* gate; float gs;
    __device__ __forceinline__ void operator()(const f32x4 (&acc)[2][2][4][2], const Unit& u, int wr, int wc, int fr, int fq) const {
        const int row0 = u.pm * BM + wr * 64 + fr, col0 = u.pn * BM + wc * 32 + 4 * fq;
        const float* gp = gate + (size_t)(u.pm / 32) * 9216;
#pragma unroll
        for (int bj = 0; bj < 2; ++bj)
#pragma unroll
            for (int n = 0; n < 2; ++n) { const int c = col0 + bj * HALF + n * 16; const f32x4 gt = *(const f32x4*)(gp + c) * gs;
#pragma unroll
                for (int ai = 0; ai < 2; ++ai)
#pragma unroll
                    for (int m = 0; m < 4; ++m) { const size_t off = (size_t)(row0 + ai * HALF + m * 16) * 1024 + c;
                        *(f32x4*)(out + off) = *(const f32x4*)(base + off) + gt * acc[ai][bj][m][n]; } }
    }
};

struct EpiResidN {
    static constexpr bool PERM = false, AFTER_DRAIN = false;
    const float* base; float* out; const float* gate; float gs; bf16_t* xn; const float* gnorm; const float* scale; float* rss;
    __device__ __forceinline__ void operator()(const f32x4 (&acc)[2][2][4][2], const Unit& u, int wr, int wc, int fr, int fq) const {
        const int row0 = u.pm * BM + wr * 64 + fr, col0 = u.pn * BM + wc * 32 + 4 * fq;
        const float* gp = gate + (size_t)(u.pm / 32) * 9216 + col0; const float* sp = scale + (size_t)(u.pm / 32) * 9216 + col0; const float* np = gnorm + col0;
#pragma unroll
        for (int ai = 0; ai < 2; ++ai)
#pragma unroll
            for (int m = 0; m < 4; ++m) {
                const int row = row0 + ai * HALF + m * 16; float ss = 0.f;
#pragma unroll
                for (int bj = 0; bj < 2; ++bj)
#pragma unroll
                    for (int n = 0; n < 2; ++n) { const int cl = bj * HALF + n * 16;
                        const f32x4 gt = *(const f32x4*)(gp + cl) * gs, gsv = *(const f32x4*)(np + cl) * (*(const f32x4*)(sp + cl) + 1.0f);
                        const unsigned off = (unsigned)(row * 1024 + col0 + cl);
                        const f32x4 o = *(const f32x4*)(base + off) + gt * acc[ai][bj][m][n];
                        *(f32x4*)(out + off) = o;
                        ss += (o[0] * o[0] + o[1] * o[1]) + (o[2] * o[2] + o[3] * o[3]);
                        const f32x4 h = o * gsv;
                        u32x2 w; w.x = cvt_pk_bf16(h[0], h[1]); w.y = cvt_pk_bf16(h[2], h[3]);
                        *(u32x2*)(xn + off) = w; }
                ss += __shfl_xor(ss, 16); ss += __shfl_xor(ss, 32);
                if (fq == 0) rss[(unsigned)(row * 16 + u.pn * 4 + wc)] = ss;
                if (m & 1) asm volatile("" ::: "memory");
            }
    }
};
__device__ __forceinline__ float row_rstd(const float* rss, int row) {
    const f32x4* p = (const f32x4*)(rss + (size_t)row * 16);
    const f32x4 a = p[0], b = p[1], c = p[2], d = p[3];
    const float s = ((a[0] + a[1]) + (a[2] + a[3])) + ((b[0] + b[1]) + (b[2] + b[3])) + ((c[0] + c[1]) + (c[2] + c[3])) + ((d[0] + d[1]) + (d[2] + d[3]));
    return 1.0f / sqrtf(s * (1.0f / 1024.0f) + 1e-6f);
}
struct EpiBf16N {
    static constexpr bool PERM = true, AFTER_DRAIN = false;
    bf16_t* O; int ldc; const float* rss; const float* bias; int nbias;
    __device__ __forceinline__ void operator()(const f32x4 (&acc)[2][2][4][2], const Unit& u, int wr, int wc, int fr, int fq) const {
        const int row0 = u.pm * BM + wr * 64 + fr, col0 = u.pn * BM + wc * 32 + 8 * fq;
        const float* bp = bias + (size_t)(u.pm / 32) * nbias + col0;
        f32x4 bv[2][2];
#pragma unroll
        for (int bj = 0; bj < 2; ++bj)
#pragma unroll
            for (int n = 0; n < 2; ++n) bv[bj][n] = *(const f32x4*)(bp + bj * HALF + 4 * n);
#pragma unroll
        for (int ai = 0; ai < 2; ++ai)
#pragma unroll
            for (int m = 0; m < 4; ++m) { const int row = row0 + ai * HALF + m * 16; const float rs = row_rstd(rss, row); bf16_t* rowp = O + (size_t)row * ldc + col0;
#pragma unroll
                for (int bj = 0; bj < 2; ++bj) { const f32x4 v0 = acc[ai][bj][m][0] * rs + bv[bj][0], v1 = acc[ai][bj][m][1] * rs + bv[bj][1];
                    u32x4 w; w.x = cvt_pk_bf16(v0[0], v0[1]); w.y = cvt_pk_bf16(v0[2], v0[3]); w.z = cvt_pk_bf16(v1[0], v1[1]); w.w = cvt_pk_bf16(v1[2], v1[3]);
                    *(u32x4*)(rowp + bj * HALF) = w; } }
    }
};
struct EpiSwigluN {
    static constexpr bool PERM = true, AFTER_DRAIN = false;
    bf16_t* O; int ldc; const float* rss; const float* bias; int nbias;
    __device__ __forceinline__ void operator()(const f32x4 (&acc)[2][2][4][2], const Unit& u, int wr, int wc, int fr, int fq) const {
        const int row0 = u.pm * BM + wr * 64 + fr, col0 = u.pn * HALF + wc * 32 + 8 * fq;
        const float* bp = bias + (size_t)(u.pm / 32) * nbias + u.pn * BM + wc * 32 + 8 * fq;
        const f32x4 bg0 = *(const f32x4*)(bp), bg1 = *(const f32x4*)(bp + 4), bu0 = *(const f32x4*)(bp + HALF), bu1 = *(const f32x4*)(bp + HALF + 4);
#pragma unroll
        for (int ai = 0; ai < 2; ++ai)
#pragma unroll
            for (int m = 0; m < 4; ++m) { const int row = row0 + ai * HALF + m * 16; const float rs = row_rstd(rss, row); bf16_t* rowp = O + (size_t)row * ldc + col0;
                const f32x4 g0 = acc[ai][0][m][0] * rs + bg0, g1 = acc[ai][0][m][1] * rs + bg1, u0 = acc[ai][1][m][0] * rs + bu0, u1 = acc[ai][1][m][1] * rs + bu1;
                u32x4 w;
                w.x = cvt_pk_bf16(silu_fast(g0[0]) * u0[0], silu_fast(g0[1]) * u0[1]); w.y = cvt_pk_bf16(silu_fast(g0[2]) * u0[2], silu_fast(g0[3]) * u0[3]);
                w.z = cvt_pk_bf16(silu_fast(g1[0]) * u1[0], silu_fast(g1[1]) * u1[1]); w.w = cvt_pk_bf16(silu_fast(g1[2]) * u1[2], silu_fast(g1[3]) * u1[3]);
                *(u32x4*)rowp = w; }
    }
};
template <class Epi, class Sched, bool ALIGN_EPI = false, bool SP2 = false>
__device__ __forceinline__ void gemm_phase(PG8_LAS unsigned char* lds, const Gemm g, const Sched& S, const Epi& E) {
    const int tid = threadIdx.x, wid = __builtin_amdgcn_readfirstlane(tid >> 6), lane = tid & 63, wr = wid >> 2, wc = wid & 3, fr = lane & 15, fq = lane >> 4;
    const int K = g.K, nt = K / BK;
    unsigned voffA[2], voffB[2];
#pragma unroll
    for (int i = 0; i < 2; ++i) { int R, C; stage_rc(tid * 16 + i * 8192, R, C); const int Rb = Epi::PERM ? ((R & ~31) + perm32(R & 31)) : R;
        voffA[i] = (unsigned)(R * K + C) * 2u; voffB[i] = (unsigned)(Rb * K + C) * 2u; }
    const size_t kstep = (size_t)(BK * 2);
    const size_t hstep = (size_t)HALF * K * 2;
    const size_t tstep = 2 * hstep;
    const unsigned ldsw = (unsigned)wid * 1024u;
    const int aoff = lds_byte(wr * 64 + fr, fq * 8), boff = lds_byte(wc * 32 + fr, fq * 8);
#define PG8_SA(b, h) (((b) * 2 + (h)) * HTB)
#define PG8_SB(b, h) ((4 + (b) * 2 + (h)) * HTB)
#define PG8_STAGE(bufoff, gbase, voff) do { _Pragma("unroll") for (int _i = 0; _i < 2; ++_i) \
        __builtin_amdgcn_global_load_lds((const unsigned*)((const char*)(gbase) + (voff)[_i]), (PG8_LAS unsigned*)(lds + (bufoff) + ldsw + _i * 8192), 16, 0, 0); } while (0)
#define PG8_LDA(dst, b, h) do { _Pragma("unroll") for (int m = 0; m < 4; ++m) _Pragma("unroll") for (int k = 0; k < 2; ++k) dst[m][k] = *(const PG8_LAS bf16x8*)(lds + PG8_SA(b, h) + aoff + m * 2048 + k * 1024); } while (0)
#define PG8_LDB(dst, b, h) do { _Pragma("unroll") for (int n = 0; n < 2; ++n) _Pragma("unroll") for (int k = 0; k < 2; ++k) dst[n][k] = *(const PG8_LAS bf16x8*)(lds + PG8_SB(b, h) + boff + n * 2048 + k * 1024); } while (0)
#define PG8_MMA(ai, bj, At, Bt) do { __builtin_amdgcn_s_setprio(1); _Pragma("unroll") for (int m = 0; m < 4; ++m) _Pragma("unroll") for (int n = 0; n < 2; ++n) _Pragma("unroll") for (int k = 0; k < 2; ++k) \
        acc[ai][bj][m][n] = __builtin_amdgcn_mfma_f32_16x16x32_bf16(Bt[n][k], At[m][k], acc[ai][bj][m][n], 0, 0, 0); __builtin_amdgcn_s_setprio(0); } while (0)
#define PG8_WAIT_V(n) asm volatile("s_waitcnt vmcnt(" #n ")" ::: "memory")
#define PG8_WAIT_L(n) asm volatile("s_waitcnt lgkmcnt(" #n ")" ::: "memory")
#define PG8_BAR __builtin_amdgcn_s_barrier()
#define PG8_SCHED __builtin_amdgcn_sched_barrier(0)
    Unit cur, nxt; int ui = 0;
    if (!S.next(0, cur)) return;
    f32x4 acc[2][2][4][2];
#pragma unroll
    for (int a = 0; a < 2; ++a)
#pragma unroll
        for (int b = 0; b < 2; ++b)
#pragma unroll
            for (int m = 0; m < 4; ++m)
#pragma unroll
                for (int n = 0; n < 2; ++n) acc[a][b][m][n] = (f32x4){0.f, 0.f, 0.f, 0.f};
    bf16x8 At[4][2], B0[2][2], B1[2][2];
    const char* cA = (const char*)g.A + (size_t)cur.pm * tstep; const char* cB = (const char*)g.Bt + (size_t)cur.pn * tstep;
    S.a_ready(cur);
    if constexpr (SP2) {
        PG8_STAGE(PG8_SB(0, 0), cB, voffB); PG8_STAGE(PG8_SB(0, 1), cB + hstep, voffB); PG8_STAGE(PG8_SA(0, 0), cA, voffA); PG8_STAGE(PG8_SA(0, 1), cA + hstep, voffA);
        if (wr == 1) PG8_BAR;
        PG8_WAIT_V(2); PG8_BAR;
        PG8_STAGE(PG8_SB(1, 0), cB + kstep, voffB); PG8_STAGE(PG8_SA(1, 0), cA + kstep, voffA); PG8_STAGE(PG8_SB(1, 1), cB + hstep + kstep, voffB);
        PG8_WAIT_V(6); PG8_BAR;
    } else {
        PG8_STAGE(PG8_SB(0, 0), cB, voffB); PG8_STAGE(PG8_SA(0, 0), cA, voffA); PG8_STAGE(PG8_SB(0, 1), cB + hstep, voffB); PG8_STAGE(PG8_SA(0, 1), cA + hstep, voffA);
        if (wr == 1) PG8_BAR;
        PG8_WAIT_V(4); PG8_BAR;
        PG8_STAGE(PG8_SB(1, 0), cB + kstep, voffB); PG8_STAGE(PG8_SA(1, 0), cA + kstep, voffA); PG8_STAGE(PG8_SB(1, 1), cB + hstep + kstep, voffB);
        PG8_WAIT_V(6); PG8_BAR;
    }
    for (;;) {
        const bool has_next = S.next(ui + 1, nxt);
        const char* nA = has_next ? (const char*)g.A + (size_t)nxt.pm * tstep : cA; const char* nB = has_next ? (const char*)g.Bt + (size_t)nxt.pn * tstep : cB;
        for (int t = 0; t < nt; t += 2) {
            const bool last = (t == nt - 2);
            const char* a1 = cA + (size_t)(t + 1) * kstep;
            const char* a2 = last ? nA : cA + (size_t)(t + 2) * kstep; const char* b2 = last ? nB : cB + (size_t)(t + 2) * kstep;
            const char* a3 = a2 + kstep; const char* b3 = b2 + kstep;
            if (last && has_next) S.a_ready(nxt);
            if constexpr (SP2) {
            PG8_LDB(B0, 0, 0); PG8_LDB(B1, 0, 1); PG8_SCHED; PG8_LDA(At, 0, 0); PG8_STAGE(PG8_SA(1, 1), a1 + hstep, voffA);
            PG8_WAIT_V(8); PG8_WAIT_L(0); PG8_BAR; PG8_MMA(0, 0, At, B0); PG8_MMA(0, 1, At, B1); PG8_BAR; PG8_SCHED;
            PG8_LDA(At, 0, 1); PG8_STAGE(PG8_SB(0, 0), b2, voffB); PG8_STAGE(PG8_SB(0, 1), b2 + hstep, voffB); PG8_STAGE(PG8_SA(0, 0), a2, voffA);
            PG8_WAIT_V(8); PG8_WAIT_L(0); PG8_BAR; PG8_MMA(1, 0, At, B0); PG8_MMA(1, 1, At, B1); PG8_BAR; PG8_SCHED;
            PG8_LDB(B0, 1, 0); PG8_LDB(B1, 1, 1); PG8_SCHED; PG8_LDA(At, 1, 0); PG8_STAGE(PG8_SA(0, 1), a2 + hstep, voffA);
            PG8_WAIT_V(8); PG8_WAIT_L(0); PG8_BAR; PG8_MMA(0, 0, At, B0); PG8_MMA(0, 1, At, B1); PG8_BAR; PG8_SCHED;
            PG8_LDA(At, 1, 1); PG8_STAGE(PG8_SB(1, 0), b3, voffB); PG8_STAGE(PG8_SB(1, 1), b3 + hstep, voffB); PG8_STAGE(PG8_SA(1, 0), a3, voffA);
            PG8_WAIT_V(8); PG8_WAIT_L(0); PG8_BAR; PG8_MMA(1, 0, At, B0); PG8_MMA(1, 1, At, B1); PG8_BAR; PG8_SCHED;
            } else {
            PG8_LDB(B0, 0, 0); PG8_SCHED; PG8_LDA(At, 0, 0); PG8_STAGE(PG8_SA(1, 1), a1 + hstep, voffA);
            PG8_WAIT_L(8); PG8_BAR; PG8_WAIT_L(0); PG8_MMA(0, 0, At, B0); PG8_BAR; PG8_SCHED;
            PG8_LDB(B1, 0, 1); PG8_STAGE(PG8_SB(0, 0), b2, voffB);
            PG8_BAR; PG8_WAIT_L(0); PG8_MMA(0, 1, At, B1); PG8_BAR;
            PG8_LDA(At, 0, 1); PG8_STAGE(PG8_SA(0, 0), a2, voffA);
            PG8_BAR; PG8_WAIT_L(0); PG8_MMA(1, 0, At, B0); PG8_BAR; PG8_SCHED;
            PG8_STAGE(PG8_SB(0, 1), b2 + hstep, voffB);
            PG8_WAIT_V(6); PG8_BAR; PG8_MMA(1, 1, At, B1); PG8_BAR;
            PG8_LDB(B0, 1, 0); PG8_SCHED; PG8_LDA(At, 1, 0); PG8_STAGE(PG8_SA(0, 1), a2 + hstep, voffA);
            PG8_WAIT_L(8); PG8_BAR; PG8_WAIT_L(0); PG8_MMA(0, 0, At, B0); PG8_BAR; PG8_SCHED;
            PG8_LDB(B1, 1, 1); PG8_STAGE(PG8_SB(1, 0), b3, voffB);
            PG8_BAR; PG8_WAIT_L(0); PG8_MMA(0, 1, At, B1); PG8_BAR;
            PG8_LDA(At, 1, 1); PG8_STAGE(PG8_SA(1, 0), a3, voffA);
            PG8_BAR; PG8_WAIT_L(0); PG8_MMA(1, 0, At, B0); PG8_BAR; PG8_SCHED;
            PG8_STAGE(PG8_SB(1, 1), b3 + hstep, voffB);
            PG8_WAIT_V(6); PG8_BAR; PG8_MMA(1, 1, At, B1); PG8_BAR;
            }
        }
        if constexpr (ALIGN_EPI) { if (wr == 0) PG8_BAR; }
        if constexpr (!Epi::AFTER_DRAIN) { E(acc, cur, wr, wc, fr, fq); S.done(cur); }
        if (!has_next) break;
#pragma unroll
        for (int a = 0; a < 2; ++a)
#pragma unroll
            for (int b = 0; b < 2; ++b)
#pragma unroll
                for (int m = 0; m < 4; ++m)
#pragma unroll
                    for (int n = 0; n < 2; ++n) acc[a][b][m][n] = (f32x4){0.f, 0.f, 0.f, 0.f};
        cur = nxt; cA = nA; cB = nB; ++ui;
        if constexpr (ALIGN_EPI) { if (wr == 1) PG8_BAR; }
    }
    PG8_WAIT_V(0);
    if constexpr (!ALIGN_EPI) { if (wr == 0) PG8_BAR; }
    PG8_BAR;
    if constexpr (Epi::AFTER_DRAIN) { E.fused(acc, cur, wr, wc, fr, fq, lds, wid, lane); S.done(cur); }
#undef PG8_SA
#undef PG8_SB
#undef PG8_STAGE
#undef PG8_LDA
#undef PG8_LDB
#undef PG8_MMA
#undef PG8_WAIT_V
#undef PG8_WAIT_L
#undef PG8_BAR
#undef PG8_SCHED
}
}

__device__ __forceinline__ void ph_mod_partial(const Params& P, unsigned char* lds) {
    const int lane = threadIdx.x & 63, wave = __builtin_amdgcn_readfirstlane(threadIdx.x >> 6);
    const int gw = blockIdx.x * NWV + wave, NGW = gridDim.x * NWV;
    float* modp = (float*)(P.ws + WS_MODP);
    float* ca = (float*)(lds + 131072);
    for (int e = threadIdx.x; e < 2 * DM; e += NTHR) ca[e] = silu_f(P.c[e]);
    __syncthreads();
    for (int it = gw; it < 144 * 16; it += NGW) {
        const int cgp = it % 144, ks = it / 144, n = cgp * 64 + lane;
        float a0 = 0.f, a1 = 0.f;
        const float* wp = P.w_ada + (size_t)(ks * 64) * NMODC + n;
#pragma unroll 16
        for (int kk = 0; kk < 64; ++kk) {
            const float w = wp[(size_t)kk * NMODC];
            a0 += ca[ks * 64 + kk] * w; a1 += ca[DM + ks * 64 + kk] * w;
        }
        modp[(size_t)(ks * 2 + 0) * NMODC + n] = a0; modp[(size_t)(ks * 2 + 1) * NMODC + n] = a1;
    }
}

template <bool FRAG = false>
__device__ __forceinline__ void tr_item(const float* W, int K, int N, bf16_t* WT, int dest_row0, float* scr, int k0, int n0, int lane) {
    const int nn = n0 + (lane & 31); const bool ok = nn < N;
#pragma unroll
    for (int i = 0; i < 32; ++i) { const int kk = 2 * i + (lane >> 5); scr[kk * 33 + (lane & 31)] = ok ? W[(size_t)(k0 + kk) * N + nn] : 0.f; }
    WSYNC();
    const int c = lane & 7;
#pragma unroll
    for (int j = 0; j < 4; ++j) { const int n = (lane >> 3) + 8 * j; const float* sp = scr + (8 * c) * 33 + n;
        u32x4 o; o.x = pk2(sp[0 * 33], sp[1 * 33]); o.y = pk2(sp[2 * 33], sp[3 * 33]); o.z = pk2(sp[4 * 33], sp[5 * 33]); o.w = pk2(sp[6 * 33], sp[7 * 33]);
        if (FRAG) { const int nn2 = dest_row0 + n, kk2 = k0 + 8 * c;
            *(u32x4*)(WT + ((size_t)(((nn2 >> 5) * (K >> 4) + (kk2 >> 4)) * 64 + ((kk2 >> 3) & 1) * 32 + (nn2 & 31)) << 3)) = o; }
        else *(u32x4*)(WT + (size_t)(dest_row0 + n) * K + k0 + 8 * c) = o; }
    WSYNC();
}
__device__ __forceinline__ void ph_weights(const Params& P, unsigned char* lds) {
    const int lane = threadIdx.x & 63, wave = __builtin_amdgcn_readfirstlane(threadIdx.x >> 6);
    const int gw = blockIdx.x * NWV + wave, NGW = gridDim.x * NWV;
    float* scr = (float*)(lds + wave * 16384);
    constexpr int I_GU = 16 * 88, I_D = 44 * 32, I_IN = 16 * 96, I_OUT = 16 * 32, I_C1 = 32 * 8, I_C2 = 4 * 2, I_B1 = 2 * 32 * 4;
    constexpr int NIT = 4 * I_GU + 2 * I_D + I_IN + I_OUT + 2 * I_C1 + 2 * I_C2 + I_B1;
    for (int it = gw; it < NIT; it += NGW) {
        int r = it;
        if (r < 4 * I_GU) {
            const int w = r / I_GU; r -= w * I_GU; const int kb = r / 88, nb = r % 88, n0 = nb * 32;
            const float* W = (w == 0) ? P.w1g : (w == 1) ? P.w1u : (w == 2) ? P.w2g : P.w2u;
            bf16_t* WT = (bf16_t*)(P.ws + ((w < 2) ? WS_W1GU : WS_W2GU));
            tr_item(W, DM, DFF, WT, 256 * (n0 >> 7) + (n0 & 127) + ((w & 1) ? 128 : 0), scr, kb * 64, n0, lane);
            continue;
        }
        r -= 4 * I_GU;
        if (r < 2 * I_D) {
            const int w = r / I_D; r -= w * I_D; const int kb = r / 32, nb = r % 32;
            tr_item(w ? P.w2d : P.w1d, DFF, DM, (bf16_t*)(P.ws + (w ? WS_W2D : WS_W1D)), nb * 32, scr, kb * 64, nb * 32, lane);
            continue;
        }
        r -= 2 * I_D;
        if (r < I_IN) { const int kb = r / 96, nb = r % 96; tr_item(P.w_in, DM, INW, (bf16_t*)(P.ws + WS_WIN), nb * 32, scr, kb * 64, nb * 32, lane); continue; }
        r -= I_IN;
        if (r < I_OUT) { const int kb = r / 32, nb = r % 32; tr_item(P.w_out, DM, DM, (bf16_t*)(P.ws + WS_WOUT), nb * 32, scr, kb * 64, nb * 32, lane); continue; }
        r -= I_OUT;
        if (r < 2 * I_C1) { const int X = r / I_C1; r -= X * I_C1; const int kb = r / 8, nb = r % 8;
            tr_item<true>(X ? P.wcv1 : P.wck1, 2048, 256, (bf16_t*)(P.ws + (X ? WS_WC1V : WS_WC1K)), nb * 32, scr, kb * 64, nb * 32, lane); continue; }
        r -= 2 * I_C1;
        if (r < 2 * I_C2) { const int X = r / I_C2; r -= X * I_C2; const int kb = r / 2, nb = r % 2;
            tr_item(X ? P.wcv2 : P.wck2, 256, 64, (bf16_t*)(P.ws + (X ? WS_WC2V : WS_WC2K)), nb * 32, scr, kb * 64, nb * 32, lane); continue; }
        r -= 2 * I_C2;
        {
            const int X = r >> 7, ks = (r >> 2) & 31, n = (r & 3) * 64 + lane;
            const float* W1 = X ? P.wcv1 : P.wck1; const float* pe = X ? P.cpv : P.cpk;
            float a = 0.f;
            for (int kk = 0; kk < 64; ++kk) { const int k = ks * 64 + kk; a += pe[k] * W1[(size_t)k * 256 + n]; }
            ((float*)(P.ws + WS_B1P))[(X * 32 + ks) * 256 + n] = a;
        }
    }
}

__device__ __forceinline__ void ph_bias_gemv(const Params& P, const bf16_t* Wt, int N, int idx_shift) {
    const int lane = threadIdx.x & 63, wave = __builtin_amdgcn_readfirstlane(threadIdx.x >> 6);
    const int gw = blockIdx.x * NWV + wave, NGW = gridDim.x * NWV;
    const float* mod = (const float*)(P.ws + WS_MOD);
    float* bias = (float*)(P.ws + WS_BIAS);
    float s0[16], s1[16];
#pragma unroll
    for (int q = 0; q < 4; ++q) { const f32x4 a = *(const f32x4*)(mod + idx_shift * DM + lane * 16 + q * 4), b = *(const f32x4*)(mod + NMODC + idx_shift * DM + lane * 16 + q * 4);
        s0[4 * q] = a[0]; s0[4 * q + 1] = a[1]; s0[4 * q + 2] = a[2]; s0[4 * q + 3] = a[3]; s1[4 * q] = b[0]; s1[4 * q + 1] = b[1]; s1[4 * q + 2] = b[2]; s1[4 * q + 3] = b[3]; }
    for (int n = gw; n < N; n += NGW) {
        float w[16]; { float t[8]; ld8(Wt + (size_t)n * DM + lane * 16, t);
#pragma unroll
            for (int e2 = 0; e2 < 8; ++e2) w[e2] = t[e2];
            ld8(Wt + (size_t)n * DM + lane * 16 + 8, t);
#pragma unroll
            for (int e2 = 0; e2 < 8; ++e2) w[8 + e2] = t[e2]; }
        float a0 = 0.f, a1 = 0.f;
#pragma unroll
        for (int e2 = 0; e2 < 16; ++e2) { a0 += s0[e2] * w[e2]; a1 += s1[e2] * w[e2]; }
        a0 = wave_sum(a0); a1 = wave_sum(a1);
        if (lane == 0) { bias[n] = a0; bias[N + n] = a1; }
    }
}
__device__ __forceinline__ void ph_norm(const Params& P, unsigned char* lds, const float* src, const float* g, int idx_shift, bool from_partials) {
    const int tid = threadIdx.x, lane = tid & 63, wave = __builtin_amdgcn_readfirstlane(tid >> 6);
    float* sh = (float*)lds;
    const float* modp = (const float*)(P.ws + WS_MODP);
    float* mod = (float*)(P.ws + WS_MOD);
    bf16_t* dst = (bf16_t*)(P.ws + WS_XN);
    if (from_partials) {
        for (int e = blockIdx.x * NTHR + tid; e < 2 * NMODC; e += gridDim.x * NTHR) {
            const int b = e / NMODC, n = e % NMODC; float v = P.b_ada[n];
            for (int ks = 0; ks < 16; ++ks) v += modp[(size_t)(ks * 2 + b) * NMODC + n];
            mod[e] = v;
        }
    }
    for (int chunk = blockIdx.x; chunk < 256; chunk += gridDim.x) {
        const int b = chunk / 128;
        __syncthreads();
        for (int ci = tid; ci < 2048; ci += NTHR) {
            const int n = idx_shift * DM + ci; float v;
            if (from_partials) { v = P.b_ada[n]; for (int ks = 0; ks < 16; ++ks) v += modp[(size_t)(ks * 2 + b) * NMODC + n]; }
            else v = mod[b * NMODC + n];
            sh[ci] = v;
        }
        __syncthreads();
        for (int r = 0; r < 8; r += 4) {
            const int row = chunk * 64 + wave * 8 + r;
            f32x4 v[4][4]; float ss[4];
#pragma unroll
            for (int q = 0; q < 4; ++q) { const f32x4* xr = (const f32x4*)(src + (size_t)(row + q) * DM) + lane;
#pragma unroll
                for (int j = 0; j < 4; ++j) v[q][j] = xr[64 * j]; }
#pragma unroll
            for (int q = 0; q < 4; ++q) { float a = 0.f;
#pragma unroll
                for (int j = 0; j < 4; ++j) a += (v[q][j].x * v[q][j].x + v[q][j].y * v[q][j].y) + (v[q][j].z * v[q][j].z + v[q][j].w * v[q][j].w);
                ss[q] = a; }
#pragma unroll
            for (int o2 = 1; o2 < 64; o2 <<= 1) {
#pragma unroll
                for (int q = 0; q < 4; ++q) ss[q] += __shfl_xor(ss[q], o2); }
#pragma unroll
            for (int j = 0; j < 4; ++j) {
                const int col = 256 * j + 4 * lane;
                const f32x4 gg = *(const f32x4*)(g + col), s4 = *(const f32x4*)(sh + col), c4 = *(const f32x4*)(sh + 1024 + col);
                const f32x4 gm = gg * (c4 + 1.0f);
#pragma unroll
                for (int q = 0; q < 4; ++q) {
                    const float rstd = 1.0f / sqrtf(ss[q] * (1.0f / DM) + EPS);
                    const f32x4 o = v[q][j] * rstd * gm + s4;
                    u32x2 w; w.x = pk2(o.x, o.y); w.y = pk2(o.z, o.w);
                    *(u32x2*)(dst + (size_t)(row + q) * DM + col) = w;
                }
            }
        }
    }
}
__device__ __forceinline__ void ph_final_norm(const Params& P) {
    const int lane = threadIdx.x & 63, wave = __builtin_amdgcn_readfirstlane(threadIdx.x >> 6);
    const int gw = blockIdx.x * NWV + wave, NGW = gridDim.x * NWV;
    f32x4 gg[4];
#pragma unroll
    for (int j = 0; j < 4; ++j) gg[j] = *(const f32x4*)(P.g_final + 256 * j + 4 * lane);
    for (int row0 = gw * 4; row0 < T; row0 += NGW * 4) {
        f32x4 v[4][4]; float ss[4];
#pragma unroll
        for (int q = 0; q < 4; ++q) { const f32x4* xr = (const f32x4*)(P.out + (size_t)(row0 + q) * DM) + lane;
#pragma unroll
            for (int j = 0; j < 4; ++j) v[q][j] = xr[64 * j]; }
#pragma unroll
        for (int q = 0; q < 4; ++q) { float a = 0.f;
#pragma unroll
            for (int j = 0; j < 4; ++j) a += (v[q][j].x * v[q][j].x + v[q][j].y * v[q][j].y) + (v[q][j].z * v[q][j].z + v[q][j].w * v[q][j].w);
            ss[q] = a; }
#pragma unroll
        for (int o2 = 1; o2 < 64; o2 <<= 1) {
#pragma unroll
            for (int q = 0; q < 4; ++q) ss[q] += __shfl_xor(ss[q], o2); }
#pragma unroll
        for (int q = 0; q < 4; ++q) { const float rstd = 1.0f / sqrtf(ss[q] * (1.0f / DM) + EPS);
            f32x4* xr = (f32x4*)(P.out + (size_t)(row0 + q) * DM) + lane;
#pragma unroll
            for (int j = 0; j < 4; ++j) xr[64 * j] = v[q][j] * rstd * gg[j]; }
    }
}

__device__ __forceinline__ int ktile_off(int kv, int d) {
    const int j = kv >> 6, kl = kv & 63, mb = kl >> 5, r32 = kl & 31, ds = d >> 4, hi = (d >> 3) & 1, e = d & 7;
    return j * 4096 + (((mb * 4 + ds) * 64 + hi * 32 + r32) << 3) + e;
}
__device__ __forceinline__ int vtile_off(int kv, int d) {
    const int j = kv >> 6, kl = kv & 63, ks = kl >> 4, w = kl & 15, hi = (w >> 2) & 1, e = (w & 3) | ((w >> 3) << 2), d0 = d >> 5, r32 = d & 31;
    return j * 4096 + (((d0 * 4 + ks) * 64 + hi * 32 + r32) << 3) + e;
}
__device__ __forceinline__ void up8(const u32x4 w, float (&v)[8]) {
    v[0] = bf2f(w.x & 0xffffu); v[1] = bf2f(w.x >> 16); v[2] = bf2f(w.y & 0xffffu); v[3] = bf2f(w.y >> 16);
    v[4] = bf2f(w.z & 0xffffu); v[5] = bf2f(w.z >> 16); v[6] = bf2f(w.w & 0xffffu); v[7] = bf2f(w.w >> 16);
}
__device__ __forceinline__ void ph_post(const Params& P) {
    const int lane = threadIdx.x & 63, wave = __builtin_amdgcn_readfirstlane(threadIdx.x >> 6);
    const int gw = blockIdx.x * NWV + wave, NGW = gridDim.x * NWV;
    const bf16_t* PROJ = (const bf16_t*)(P.ws + WS_BIG);
    bf16_t* Y = (bf16_t*)(P.ws + WS_Y);
    bf16_t* Qr = (bf16_t*)(P.ws + WS_Q);
    const int ch = lane * 8, chunk = lane & 7;
    float w0[8], w1[8], w2[8], gc[8];
#pragma unroll
    for (int e = 0; e < 8; ++e) { w0[e] = P.conv_w[ch + e]; w1[e] = P.conv_w[512 + ch + e]; w2[e] = P.conv_w[1024 + ch + e]; gc[e] = P.goc[ch + e]; }
    const bool act1 = lane < 32;
    for (int t0 = gw * 8; t0 < T; t0 += NGW * 8) {
        const int b = t0 / SEQ, sb = t0 % SEQ;
        const bf16_t* pr = PROJ + (size_t)t0 * PJ;
        float u1[8], u2[8];
#pragma unroll
        for (int e = 0; e < 8; ++e) { u1[e] = 0.f; u2[e] = 0.f; }
        if (sb >= 2) {
            float c1[8], x1[8], c2[8], x2[8];
            up8(*(const u32x4*)(pr - PJ + C_CC + ch), c1); up8(*(const u32x4*)(pr - PJ + C_CX + ch), x1);
            up8(*(const u32x4*)(pr - 2 * PJ + C_CC + ch), c2); up8(*(const u32x4*)(pr - 2 * PJ + C_CX + ch), x2);
#pragma unroll
            for (int e = 0; e < 8; ++e) { u1[e] = c1[e] * x1[e]; u2[e] = c2[e] * x2[e]; }
        }
        const u32x4 zz = {0u, 0u, 0u, 0u};
        u32x4 rcb = *(const u32x4*)(pr + C_CB + ch), rcc = *(const u32x4*)(pr + C_CC + ch), rcx = *(const u32x4*)(pr + C_CX + ch), rq = *(const u32x4*)(pr + C_Q + ch);
        u32x4 rk0 = *(const u32x4*)(pr + C_KV + ch), rk1 = act1 ? *(const u32x4*)(pr + C_KV + 512 + ch) : zz;
        for (int i = 0; i < 8; ++i) {
            const int tok = t0 + i, s = sb + i;
            const u32x4 ccb = rcb, ccc = rcc, ccx = rcx, cq = rq, ck0 = rk0, ck1 = rk1;
            if (i < 7) { const bf16_t* pn = pr + (size_t)(i + 1) * PJ;
                rcb = *(const u32x4*)(pn + C_CB + ch); rcc = *(const u32x4*)(pn + C_CC + ch); rcx = *(const u32x4*)(pn + C_CX + ch); rq = *(const u32x4*)(pn + C_Q + ch);
                rk0 = *(const u32x4*)(pn + C_KV + ch); rk1 = act1 ? *(const u32x4*)(pn + C_KV + 512 + ch) : zz; }
            {
                float cb[8], c0[8], x0[8]; up8(ccb, cb); up8(ccc, c0); up8(ccx, x0);
                float y[8]; float ss = 0.f;
#pragma unroll
                for (int e = 0; e < 8; ++e) {
                    const float u0 = c0[e] * x0[e];
                    const float v = w0[e] * u2[e] + w1[e] * u1[e] + w2[e] * u0;
                    u2[e] = u1[e]; u1[e] = u0;
                    y[e] = cb[e] * v; ss += y[e] * y[e];
                }
                ss += __shfl_xor(ss, 1); ss += __shfl_xor(ss, 2); ss += __shfl_xor(ss, 4);
                const float rstd = 1.0f / sqrtf(ss * (1.0f / 64.0f) + EPS);
#pragma unroll
                for (int e = 0; e < 8; ++e) y[e] = y[e] * rstd * gc[e];
                st8(Y + (size_t)tok * DM + ch, y);
            }
            float cs[8], sn[8];
            {
                const float pf = (float)P.pos[tok];
#pragma unroll
                for (int e = 0; e < 8; ++e) {
                    constexpr float FRQ[8] = {1.0f, 0.1939227432012558f, 0.03760603070259094f, 0.007292664609849453f, 0.0014142135623842478f, 0.00027424818836152554f, 5.3182957344688475e-05f, 1.0313385246263351e-05f};
                    const float ang = pf * FRQ[e];
                    const double rev = (double)ang * 0.15915494309189535;
                    const float fx = (float)(rev - floor(rev));
                    cs[e] = __builtin_amdgcn_cosf(fx); sn[e] = __builtin_amdgcn_sinf(fx);
                }
            }
            {
                float qv[8], pv[8]; up8(cq, qv);
#pragma unroll
                for (int e = 0; e < 8; ++e) pv[e] = __shfl_xor(qv[e], 1);
#pragma unroll
                for (int e = 0; e < 8; ++e) {
                    float r = qv[e];
                    if (chunk == 0) r = qv[e] * cs[e] - pv[e] * sn[e];
                    else if (chunk == 1) r = qv[e] * cs[e] + pv[e] * sn[e];
                    qv[e] = r * QSCALE;
                }
                st8(Qr + (size_t)tok * 512 + ch, qv);
            }
#pragma unroll
            for (int p = 0; p < 2; ++p) {
                const int slot = p * 64 + lane, tensor = slot >> 4, g = (slot >> 3) & 1;
                const bool act = slot < 96;
                float kv[8], pv[8]; up8(p ? ck1 : ck0, kv);
#pragma unroll
                for (int e = 0; e < 8; ++e) pv[e] = __shfl_xor(kv[e], 1);
                if ((tensor & 1) == 0) {
#pragma unroll
                    for (int e = 0; e < 8; ++e) {
                        if (chunk == 0) kv[e] = kv[e] * cs[e] - pv[e] * sn[e];
                        else if (chunk == 1) kv[e] = kv[e] * cs[e] + pv[e] * sn[e];
                    }
                }
                if (act) {
                    bf16_t* base = (bf16_t*)(P.ws + WS_KV + (size_t)tensor * 4 * MiB) + (size_t)(b * 2 + g) * SEQ * 64;
                    if (tensor < 2) st8(base + (size_t)s * 64 + chunk * 8, kv);
                    else if ((tensor & 1) == 0) st8(base + ktile_off(s, chunk * 8), kv);
                }
            }
        }
    }
}

__device__ __forceinline__ void ph_vtiles(const Params& P, unsigned char* lds) {
    const int lane = threadIdx.x & 63, wave = __builtin_amdgcn_readfirstlane(threadIdx.x >> 6);
    const int gw = blockIdx.x * NWV + wave, NGW = gridDim.x * NWV;
    const bf16_t* PROJ = (const bf16_t*)(P.ws + WS_BIG);
    bf16_t* tl = (bf16_t*)(lds + wave * 16384);
    const int r32 = lane & 31, hi = lane >> 5;
    for (int it = gw; it < 1024; it += NGW) {
        const int j = it & 127, bg = (it >> 7) & 3, tv = it >> 9;
        const int b = bg >> 1, g = bg & 1, tensor = 3 + 2 * tv;
        const bf16_t* src = PROJ + (size_t)(b * SEQ + j * 64 + lane) * PJ + C_KV + tensor * 128 + g * 64;
        WSYNC();
#pragma unroll
        for (int c = 0; c < 8; ++c) { const u32x4 v = *(const u32x4*)(src + c * 8);
            unsigned* d = (unsigned*)(tl + lane * 66 + c * 8); d[0] = v.x; d[1] = v.y; d[2] = v.z; d[3] = v.w; }
        WSYNC();
        bf16_t* dst = (bf16_t*)(P.ws + WS_KV + (size_t)tensor * 4 * MiB) + (size_t)bg * SEQ * 64 + (size_t)j * 4096;
#pragma unroll
        for (int f = 0; f < 8; ++f) {
            const int d = 32 * (f >> 2) + r32, kb = 16 * (f & 3) + 4 * hi;
            unsigned w[4];
#pragma unroll
            for (int q = 0; q < 4; ++q) { const int e0 = 2 * q, k0 = kb + (e0 & 3) + 8 * (e0 >> 2);
                w[q] = (unsigned)tl[k0 * 66 + d] | ((unsigned)tl[(k0 + 1) * 66 + d] << 16); }
            u32x4 o; o.x = w[0]; o.y = w[1]; o.z = w[2]; o.w = w[3];
            *(u32x4*)(dst + ((f * 64 + lane) << 3)) = o;
        }
    }
}
typedef short bf16x8 __attribute__((ext_vector_type(8)));
typedef float f32x16 __attribute__((ext_vector_type(16)));
typedef float f32x2_t __attribute__((ext_vector_type(2)));
typedef __bf16 bf16x2_t __attribute__((ext_vector_type(2)));
__device__ __forceinline__ unsigned cvtpk(float lo, float hi) { f32x2_t v = {lo, hi}; bf16x2_t b = __builtin_convertvector(v, bf16x2_t); return __builtin_bit_cast(unsigned, b); }
__device__ __forceinline__ float quad_sum(float v) {
    v += __builtin_bit_cast(float, __builtin_amdgcn_update_dpp(0, __builtin_bit_cast(int, v), 0xB1, 0xF, 0xF, true));
    v += __builtin_bit_cast(float, __builtin_amdgcn_update_dpp(0, __builtin_bit_cast(int, v), 0x4E, 0xF, 0xF, true));
    return v;
}
typedef const __attribute__((address_space(1))) char* gcptr;
__device__ __forceinline__ gcptr uni_ptr(const void* p) {
    const unsigned long long v = (unsigned long long)p;
    const unsigned lo = (unsigned)__builtin_amdgcn_readfirstlane((int)(unsigned)v), hi = (unsigned)__builtin_amdgcn_readfirstlane((int)(unsigned)(v >> 32));
    return (gcptr)(((unsigned long long)hi << 32) | lo);
}
__device__ __forceinline__ void ld_frags(bf16x8 (&f)[8], const bf16_t* tile, int lane) {
    gcptr b = uni_ptr(tile); const unsigned vo = (unsigned)lane * 16u;
#pragma unroll
    for (int i = 0; i < 8; ++i) f[i] = *(const __attribute__((address_space(1))) bf16x8*)(b + vo + i * 1024);
}
__device__ __forceinline__ void qk_tile(f32x16& s0, f32x16& s1, const bf16x8 (&kf)[8], const bf16x8 (&qf)[4]) {
    const f32x16 z = {0.f, 0.f, 0.f, 0.f, 0.f, 0.f, 0.f, 0.f, 0.f, 0.f, 0.f, 0.f, 0.f, 0.f, 0.f, 0.f};
    s0 = z; s1 = z;
    __builtin_amdgcn_s_setprio(1);
#pragma unroll
    for (int ds = 0; ds < 4; ++ds) {
        s0 = __builtin_amdgcn_mfma_f32_32x32x16_bf16(kf[ds], qf[ds], s0, 0, 0, 0);
        s1 = __builtin_amdgcn_mfma_f32_32x32x16_bf16(kf[4 + ds], qf[ds], s1, 0, 0, 0);
    }
    __builtin_amdgcn_s_setprio(0);
}
__device__ __forceinline__ void pv_tile(f32x16 (&o)[2], const f32x16& p0, const f32x16& p1, const bf16x8 (&vf)[8]) {
    u32x4 w0, w1, w2, w3;
    w0.x = cvtpk(p0[0], p0[1]); w0.y = cvtpk(p0[2], p0[3]); w0.z = cvtpk(p0[4], p0[5]); w0.w = cvtpk(p0[6], p0[7]);
    w1.x = cvtpk(p0[8], p0[9]); w1.y = cvtpk(p0[10], p0[11]); w1.z = cvtpk(p0[12], p0[13]); w1.w = cvtpk(p0[14], p0[15]);
    w2.x = cvtpk(p1[0], p1[1]); w2.y = cvtpk(p1[2], p1[3]); w2.z = cvtpk(p1[4], p1[5]); w2.w = cvtpk(p1[6], p1[7]);
    w3.x = cvtpk(p1[8], p1[9]); w3.y = cvtpk(p1[10], p1[11]); w3.z = cvtpk(p1[12], p1[13]); w3.w = cvtpk(p1[14], p1[15]);
    const bf16x8 b0 = __builtin_bit_cast(bf16x8, w0), b1 = __builtin_bit_cast(bf16x8, w1), b2 = __builtin_bit_cast(bf16x8, w2), b3 = __builtin_bit_cast(bf16x8, w3);
    __builtin_amdgcn_s_setprio(1);
#pragma unroll
    for (int d0 = 0; d0 < 2; ++d0) {
        o[d0] = __builtin_amdgcn_mfma_f32_32x32x16_bf16(vf[d0 * 4 + 0], b0, o[d0], 0, 0, 0);
        o[d0] = __builtin_amdgcn_mfma_f32_32x32x16_bf16(vf[d0 * 4 + 1], b1, o[d0], 0, 0, 0);
        o[d0] = __builtin_amdgcn_mfma_f32_32x32x16_bf16(vf[d0 * 4 + 2], b2, o[d0], 0, 0, 0);
        o[d0] = __builtin_amdgcn_mfma_f32_32x32x16_bf16(vf[d0 * 4 + 3], b3, o[d0], 0, 0, 0);
    }
    __builtin_amdgcn_s_setprio(0);
}
__device__ __forceinline__ float xhalf_max(float v) {
    const auto rr = __builtin_amdgcn_permlane32_swap(__float_as_uint(v), __float_as_uint(v), false, false);
    return fmaxf(__uint_as_float(rr[0]), __uint_as_float(rr[1]));
}
__device__ __forceinline__ float xhalf_sum(float v) {
    const auto rr = __builtin_amdgcn_permlane32_swap(__float_as_uint(v), __float_as_uint(v), false, false);
    return __uint_as_float(rr[0]) + __uint_as_float(rr[1]);
}
__device__ __forceinline__ void smax_step(f32x16& s0, f32x16& s1, float& m, float& l, f32x16 (&o)[2], bool sel) {
    float x0 = fmaxf(s0[0], s1[0]), x1 = fmaxf(s0[1], s1[1]), x2 = fmaxf(s0[2], s1[2]), x3 = fmaxf(s0[3], s1[3]);
#pragma unroll
    for (int r = 4; r < 16; r += 4) {
        x0 = fmaxf(x0, fmaxf(s0[r], s1[r])); x1 = fmaxf(x1, fmaxf(s0[r + 1], s1[r + 1])); x2 = fmaxf(x2, fmaxf(s0[r + 2], s1[r + 2])); x3 = fmaxf(x3, fmaxf(s0[r + 3], s1[r + 3]));
    }
    float mx = fmaxf(fmaxf(x0, x1), fmaxf(x2, x3));
    if (!sel) mx = NEGV;
    mx = xhalf_max(mx);
    const float mn = fmaxf(m, mx);
    if (__any(mn > m)) { const float al = __builtin_amdgcn_exp2f(m - mn); l *= al; o[0] *= al; o[1] *= al; }
    m = mn;
    const float me = sel ? mn : 1e30f;
    float a0 = 0.f, a1 = 0.f, a2 = 0.f, a3 = 0.f;
#pragma unroll
    for (int r = 0; r < 16; r += 2) {
        s0[r] = __builtin_amdgcn_exp2f(s0[r] - me); s0[r + 1] = __builtin_amdgcn_exp2f(s0[r + 1] - me);
        s1[r] = __builtin_amdgcn_exp2f(s1[r] - me); s1[r + 1] = __builtin_amdgcn_exp2f(s1[r + 1] - me);
        a0 += s0[r]; a1 += s0[r + 1]; a2 += s1[r]; a3 += s1[r + 1];
    }
    l += (a0 + a1) + (a2 + a3);
}
template <int KIND>
__device__ __forceinline__ void tile_body(f32x16 (&o)[2], float& m, float& l, bf16x8 (&kf)[8], const bf16x8 (&qf)[4], const bf16_t* vtile, const bf16_t* knext, int lane,
                                          int j, int s, int s0, int cur, bool sel, int hi) {
    bf16x8 vf[8]; ld_frags(vf, vtile, lane);
    asm volatile("" ::: "memory"); __builtin_amdgcn_sched_barrier(0);
    f32x16 a0, a1; qk_tile(a0, a1, kf, qf);
    asm volatile("" ::: "memory"); __builtin_amdgcn_sched_barrier(0);
    ld_frags(kf, knext, lane);
    asm volatile("" ::: "memory"); __builtin_amdgcn_sched_barrier(0);
    const int pb = 64 * j + 4 * hi;
    if (KIND == 0) {
        if (j == cur) {
#pragma unroll
            for (int r = 0; r < 16; ++r) { const int pos = pb + (r & 3) + 8 * (r >> 2); a0[r] = (sel && pos <= s) ? a0[r] : NEGV; a1[r] = (sel && pos + 32 <= s) ? a1[r] : NEGV; }
        }
    } else {
        if (64 * j + 63 > s0 || 64 * j < s0 + 7 - 511) {
#pragma unroll
            for (int r = 0; r < 16; ++r) { const int pos = pb + (r & 3) + 8 * (r >> 2);
                a0[r] = (pos <= s && pos >= s - 511) ? a0[r] : NEGV; a1[r] = (pos + 32 <= s && pos + 32 >= s - 511) ? a1[r] : NEGV; }
        }
    }
    smax_step(a0, a1, m, l, o, KIND == 0 ? sel : true);
    pv_tile(o, a0, a1, vf);
}
__device__ __forceinline__ int next_blk(unsigned& bits, int& w, unsigned U1, unsigned U2, unsigned U3) {
    while (bits == 0u && w < 3) { ++w; bits = (w == 1) ? U1 : (w == 2) ? U2 : U3; }
    if (bits == 0u) return -1;
    const int bp = __builtin_ctz(bits); bits &= bits - 1u; return 32 * w + bp;
}
__device__ __forceinline__ void attn_unit(const Params& P, float* impA, float* impB, int bg, int tg, int lane) {
    const int b = bg >> 1, g = bg & 1, s0 = tg * 8, r32 = lane & 31, hi = lane >> 5, tl = r32 >> 2, hh = r32 & 3;
    const int s = s0 + tl, tok = b * SEQ + s, cur = s0 >> 6;
    const bf16_t* PROJ = (const bf16_t*)(P.ws + WS_BIG);
    const bf16_t* Qr = (const bf16_t*)(P.ws + WS_Q);
    bf16_t* Y = (bf16_t*)(P.ws + WS_Y);
    const bf16_t* KCt = (const bf16_t*)(P.ws + WS_KCC) + (size_t)bg * 512 * 64;
    const bf16_t* VCt = (const bf16_t*)(P.ws + WS_VCC) + (size_t)bg * 512 * 64;
    const bf16_t* KSt = (const bf16_t*)(P.ws + WS_KV + 2 * 4 * MiB) + (size_t)bg * SEQ * 64;
    const bf16_t* VSt = (const bf16_t*)(P.ws + WS_KV + 3 * 4 * MiB) + (size_t)bg * SEQ * 64;
    const bf16_t* KWt = (const bf16_t*)(P.ws + WS_KV + 4 * 4 * MiB) + (size_t)bg * SEQ * 64;
    const bf16_t* VWt = (const bf16_t*)(P.ws + WS_KV + 5 * 4 * MiB) + (size_t)bg * SEQ * 64;
    bf16x8 qf[4];
    { const bf16_t* qp = Qr + (size_t)tok * 512 + (g * 4 + hh) * 64 + hi * 8;
#pragma unroll
      for (int ds = 0; ds < 4; ++ds) qf[ds] = *(const bf16x8*)(qp + ds * 16); }
    float g0, g1, g2;
    { const bf16_t* gp = PROJ + (size_t)tok * PJ + C_GT + g * 12 + hh * 3;
      g0 = 1.0f / (1.0f + __expf(-bf2f(gp[0]))); g1 = 1.0f / (1.0f + __expf(-bf2f(gp[1]))); g2 = 1.0f / (1.0f + __expf(-bf2f(gp[2]))); }
    const f32x16 z16 = {0.f, 0.f, 0.f, 0.f, 0.f, 0.f, 0.f, 0.f, 0.f, 0.f, 0.f, 0.f, 0.f, 0.f, 0.f, 0.f};
    f32x16 ocmp[2]; ocmp[0] = z16; ocmp[1] = z16;
    {
        const f32x4 z4 = {0.f, 0.f, 0.f, 0.f};
#pragma unroll
        for (int i = 0; i < 8; ++i) *(f32x4*)(impA + ((i * 64 + lane) << 2)) = z4;
    }
    WSYNC();
    const int sm = s0 + 7;
    int nvm = (sm >= 31) ? ((sm - 31) / 16 + 1) : 0; if (nvm > 511) nvm = 511;
    int nv = (s >= 31) ? ((s - 31) / 16 + 1) : 0; if (nv > 511) nv = 511;
    const int ntc = (nvm + 63) >> 6;
    int nvlo = (s0 >= 31) ? ((s0 - 31) / 16 + 1) : 0; if (nvlo > 511) nvlo = 511;
    if (ntc > 0) {
        float m = NEGV, l = 0.f;
        for (int c = 0; c < ntc; ++c) {
            bf16x8 kf[8]; ld_frags(kf, KCt + c * 4096, lane);
            f32x16 a0, a1; qk_tile(a0, a1, kf, qf);
            const int ib = 64 * c + 4 * hi;
            const bool full = 64 * (c + 1) <= nvlo;
            float mx = NEGV;
            if (!full) {
#pragma unroll
                for (int r = 0; r < 16; ++r) { const int i0 = ib + (r & 3) + 8 * (r >> 2); a0[r] = (i0 < nv) ? a0[r] : NEGV; a1[r] = (i0 + 32 < nv) ? a1[r] : NEGV; }
            }
#pragma unroll
            for (int r = 0; r < 16; ++r) mx = fmaxf(mx, fmaxf(a0[r], a1[r]));
            mx = xhalf_max(mx);
            const float mn = fmaxf(m, mx); l *= __builtin_amdgcn_exp2f(m - mn); m = mn;
            float sum = 0.f;
            if (full) {
#pragma unroll
                for (int r = 0; r < 16; ++r) sum += __builtin_amdgcn_exp2f(a0[r] - mn) + __builtin_amdgcn_exp2f(a1[r] - mn);
            } else {
#pragma unroll
                for (int r = 0; r < 16; ++r) { const int i0 = ib + (r & 3) + 8 * (r >> 2);
                    sum += ((i0 < nv) ? __builtin_amdgcn_exp2f(a0[r] - mn) : 0.f) + ((i0 + 32 < nv) ? __builtin_amdgcn_exp2f(a1[r] - mn) : 0.f); }
            }
            l += sum;
        }
        l = xhalf_sum(l);
        const float inv = (l > 0.f) ? 1.0f / l : 0.f;
        f32x16 o[2]; o[0] = z16; o[1] = z16;
        for (int c = 0; c < ntc; ++c) {
            bf16x8 kf[8], vf[8]; ld_frags(kf, KCt + c * 4096, lane); ld_frags(vf, VCt + c * 4096, lane);
            f32x16 a0, a1; qk_tile(a0, a1, kf, qf);
            const int ib = 64 * c + 4 * hi;
            if (64 * (c + 1) <= nvlo) {
#pragma unroll
                for (int r = 0; r < 16; ++r) { a0[r] = __builtin_amdgcn_exp2f(a0[r] - m) * inv; a1[r] = __builtin_amdgcn_exp2f(a1[r] - m) * inv; }
            } else {
#pragma unroll
                for (int r = 0; r < 16; ++r) { const int i0 = ib + (r & 3) + 8 * (r >> 2);
                    a0[r] = (i0 < nv) ? __builtin_amdgcn_exp2f(a0[r] - m) * inv : 0.f; a1[r] = (i0 + 32 < nv) ? __builtin_amdgcn_exp2f(a1[r] - m) * inv : 0.f; }
            }
#pragma unroll
            for (int rr = 0; rr < 4; ++rr) {
                float sa = (a0[4 * rr] + a0[4 * rr + 1]) + (a0[4 * rr + 2] + a0[4 * rr + 3]), sb = a0[4 * rr + 3];
                float ta = (a1[4 * rr] + a1[4 * rr + 1]) + (a1[4 * rr + 2] + a1[4 * rr + 3]), tb = a1[4 * rr + 3];
                sa = quad_sum(sa); sb = quad_sum(sb); ta = quad_sum(ta); tb = quad_sum(tb);
                const int j = 16 * c + 2 * rr + hi;
                if (hh == 0) { impA[tl * 128 + j] = sa; impB[tl * 128 + j + 1] = sb; impA[tl * 128 + j + 8] = ta; if (j + 9 < 128) impB[tl * 128 + j + 9] = tb; }
            }
            pv_tile(o, a0, a1, vf);
        }
        ocmp[0] = o[0] * g0; ocmp[1] = o[1] * g0;
    }
    WSYNC();
    unsigned U0 = 0u, U1 = 0u, U2 = 0u, U3 = 0u, mk0 = 0u, mk1 = 0u, mk2 = 0u, mk3 = 0u;
    {
        const unsigned long long lt = (lane == 0) ? 0ull : (~0ull >> (64 - lane));
        const int j0 = lane, j1 = lane + 64;
        const bool c0 = (j0 >= 1) && (j0 <= cur - 2), c1 = (j1 <= cur - 2);
        const bool f0 = (j0 == 0) || (j0 == cur) || (j0 == cur - 1), f1 = (j1 == cur) || (j1 == cur - 1);
        for (int t8 = 0; t8 < 8; ++t8) {
            bool sel0, sel1;
            if (cur - 2 <= 13) { sel0 = j0 <= cur; sel1 = j1 <= cur; }
            else {
                const float v0 = impA[t8 * 128 + j0] + impB[t8 * 128 + j0], v1 = impA[t8 * 128 + j1] + impB[t8 * 128 + j1];
                const unsigned k0 = c0 ? __float_as_uint(v0) : 0u, k1 = c1 ? __float_as_uint(v1) : 0u;
                unsigned Tt = 0u;
                for (int bit = 30; bit >= 0; --bit) {
                    const unsigned tr = Tt | (1u << bit);
                    const int cnt = __popcll(__ballot(k0 >= tr)) + __popcll(__ballot(k1 >= tr));
                    if (cnt >= 13) Tt = tr;
                    if (cnt == 13) break;
                }
                const bool gt0 = c0 && (k0 > Tt), gt1 = c1 && (k1 > Tt), eq0 = c0 && (k0 == Tt), eq1 = c1 && (k1 == Tt);
                const int rem = 13 - (__popcll(__ballot(gt0)) + __popcll(__ballot(gt1)));
                const unsigned long long e0 = __ballot(eq0), e1 = __ballot(eq1);
                const bool ch0 = gt0 || (eq0 && (__popcll(e0 & lt) < rem)), ch1 = gt1 || (eq1 && ((__popcll(e0) + __popcll(e1 & lt)) < rem));
                sel0 = f0 || ch0; sel1 = f1 || ch1;
            }
            const unsigned long long b0 = __ballot(sel0), b1 = __ballot(sel1);
            const unsigned w0 = (unsigned)b0, w1 = (unsigned)(b0 >> 32), w2 = (unsigned)b1, w3 = (unsigned)(b1 >> 32);
            U0 |= w0; U1 |= w1; U2 |= w2; U3 |= w3;
            if (tl == t8) { mk0 = w0; mk1 = w1; mk2 = w2; mk3 = w3; }
        }
    }
    WSYNC();
    float* stash = impA + lane;
#pragma unroll
    for (int r = 0; r < 16; ++r) { stash[r * 64] = ocmp[0][r]; stash[(16 + r) * 64] = ocmp[1][r]; }
    {
        float m = NEGV, l = 0.f; f32x16 o[2]; o[0] = z16; o[1] = z16;
        U0 = (unsigned)__builtin_amdgcn_readfirstlane((int)U0); U1 = (unsigned)__builtin_amdgcn_readfirstlane((int)U1);
        U2 = (unsigned)__builtin_amdgcn_readfirstlane((int)U2); U3 = (unsigned)__builtin_amdgcn_readfirstlane((int)U3);
        unsigned bits = U0; int w = 0;
        int j = next_blk(bits, w, U1, U2, U3);
        bf16x8 kf[8]; ld_frags(kf, KSt + (size_t)j * 4096, lane);
        while (j >= 0) {
            const int jn = next_blk(bits, w, U1, U2, U3);
            const unsigned mw = (j < 32) ? mk0 : (j < 64) ? mk1 : (j < 96) ? mk2 : mk3;
            const bool sel = ((mw >> (j & 31)) & 1u) != 0u;
            tile_body<0>(o, m, l, kf, qf, VSt + (size_t)j * 4096, KSt + (size_t)((jn >= 0) ? jn : j) * 4096, lane, j, s, s0, cur, sel, hi);
            j = jn;
        }
        l = xhalf_sum(l);
        const float sc = g1 / l;
#pragma unroll
        for (int r = 0; r < 16; ++r) { stash[r * 64] += o[0][r] * sc; stash[(16 + r) * 64] += o[1][r] * sc; }
    }
    f32x16 oacc[2];
    {
        float m = NEGV, l = 0.f; f32x16 o[2]; o[0] = z16; o[1] = z16;
        const int jhi = s0 >> 6; const int jlo = (s0 < 511) ? 0 : ((s0 - 511) >> 6);
        bf16x8 kf[8]; ld_frags(kf, KWt + (size_t)jhi * 4096, lane);
        for (int j = jhi; j >= jlo; --j)
            tile_body<1>(o, m, l, kf, qf, VWt + (size_t)j * 4096, KWt + (size_t)((j > jlo) ? j - 1 : j) * 4096, lane, j, s, s0, cur, true, hi);
        l = xhalf_sum(l);
        const float sc = g2 / l;
#pragma unroll
        for (int r = 0; r < 16; ++r) { oacc[0][r] = stash[r * 64] + o[0][r] * sc; oacc[1][r] = stash[(16 + r) * 64] + o[1][r] * sc; }
    }
    {
        float ss = 0.f;
#pragma unroll
        for (int r = 0; r < 16; ++r) ss += oacc[0][r] * oacc[0][r] + oacc[1][r] * oacc[1][r];
        ss = xhalf_sum(ss);
        const float rstd = 1.0f / sqrtf(ss * (1.0f / 64.0f) + EPS);
        const int cb = (g * 4 + hh) * 64;
#pragma unroll
        for (int d0 = 0; d0 < 2; ++d0)
#pragma unroll
            for (int rr = 0; rr < 4; ++rr) {
                const int d = 32 * d0 + 8 * rr + 4 * hi;
                const f32x4 gg = *(const f32x4*)(P.goa + cb + d);
                u32x2 w; w.x = pk2(oacc[d0][4 * rr] * rstd * gg.x, oacc[d0][4 * rr + 1] * rstd * gg.y); w.y = pk2(oacc[d0][4 * rr + 2] * rstd * gg.z, oacc[d0][4 * rr + 3] * rstd * gg.w);
                *(u32x2*)(Y + (size_t)tok * DM + 512 + cb + d) = w;
            }
    }
    WSYNC();
}
__device__ __forceinline__ void ph_attn(const Params& P, unsigned char* lds) {
    const int lane = threadIdx.x & 63, wave = __builtin_amdgcn_readfirstlane(threadIdx.x >> 6);
    const int gw = blockIdx.x * NWV + wave, NGW = gridDim.x * NWV;
    float* impA = (float*)(lds + wave * 8192); float* impB = impA + 1024;
    unsigned* qctr = (unsigned*)(P.ws + WS_BAR) + 4096;
    const int pref = (int)(xcc_id_hw() & 3u);
    for (int k = 0; k < 4; ++k) {
        const int bg = (pref + k) & 3;
        for (;;) {
            unsigned t = 0u;
            if (lane == 0) t = __hip_atomic_fetch_add(qctr + 64 * bg, 1u, __ATOMIC_RELAXED, __HIP_MEMORY_SCOPE_AGENT);
            t = (unsigned)__builtin_amdgcn_readfirstlane((int)t);
            if (t >= 1024u) break;
            attn_unit(P, impA, impB, bg, 1023 - (int)t, lane);
        }
    }
}

__device__ __forceinline__ void ph_compress(const Params& P, unsigned char* lds) {
    const int tid = threadIdx.x, lane = tid & 63, wave = __builtin_amdgcn_readfirstlane(tid >> 6), r32 = lane & 31, hi = lane >> 5;
    unsigned char* aspan = lds;
    bf16_t* hid = (bf16_t*)(lds + 67584);
    float* bias = (float*)(lds + 67584 + 32 * 264 * 2);
    const f32x16 z16 = {0.f, 0.f, 0.f, 0.f, 0.f, 0.f, 0.f, 0.f, 0.f, 0.f, 0.f, 0.f, 0.f, 0.f, 0.f, 0.f};
    for (int it = blockIdx.x; it < 128; it += gridDim.x) {
        const int X = it >> 6, bg = (it >> 4) & 3, ch = it & 15, i0 = ch * 32;
        const bf16_t* src = (const bf16_t*)(P.ws + WS_KV + (size_t)X * 4 * MiB) + (size_t)bg * SEQ * 64;
        const bf16_t* W1t = (const bf16_t*)(P.ws + (X ? WS_WC1V : WS_WC1K));
        const bf16_t* W2t = (const bf16_t*)(P.ws + (X ? WS_WC2V : WS_WC2K));
        const float* bpp = (const float*)(P.ws + WS_B1P) + X * 32 * 256;
        bf16_t* dst = (bf16_t*)(P.ws + (X ? WS_VCC : WS_KCC)) + (size_t)bg * 512 * 64;
        __syncthreads();
        {
            const unsigned char* gs = (const unsigned char*)(src + (size_t)(16 * i0) * 64);
#pragma unroll
            for (int r = 0; r < 9; ++r) { const int e = tid + 512 * r;
                if (e < 528 * 8) { const int tk = e >> 3, c = e & 7; const u32x4 v = *(const u32x4*)(gs + (size_t)e * 16);
                    *(u32x4*)(aspan + tk * 128 + ((c ^ ((tk >> 4) & 7)) << 4)) = v; } }
        }
        if (tid < 256) { float v = 0.f;
#pragma unroll 8
            for (int ks = 0; ks < 32; ++ks) v += bpp[ks * 256 + tid];
            bias[tid] = v; }
        __syncthreads();
        f32x16 acc = z16;
        const bf16_t* bp1 = W1t + ((size_t)(wave * 128) * 64 + lane) * 8;
        bf16x8 wr[16];
#define CMP_LOAD16(dst, kb) do { } while (0)
#define CMP_MMA16(src, kb) do { } while (0)
#define CMP_FENCE() do { asm volatile("" ::: "memory"); __builtin_amdgcn_sched_barrier(0); } while (0)
#pragma unroll
        for (int q = 0; q < 16; ++q) wr[q] = *(const bf16x8*)(bp1 + (size_t)q * 512);
        CMP_FENCE();
#pragma unroll 1
        for (int kb = 0; kb < 8; ++kb) {
#pragma unroll
            for (int q = 0; q < 16; ++q) {
                const int ks = kb * 16 + q; const int tk = 16 * r32 + (ks >> 2), c = 2 * (ks & 3) + hi;
                const bf16x8 xa = *(const bf16x8*)(aspan + tk * 128 + ((c ^ ((tk >> 4) & 7)) << 4));
                acc = __builtin_amdgcn_mfma_f32_32x32x16_bf16(wr[q], xa, acc, 0, 0, 0);
                CMP_FENCE();
                wr[q] = *(const bf16x8*)(bp1 + (size_t)((kb < 7) ? ks + 16 : ks) * 512);
                CMP_FENCE();
            }
        }
#undef CMP_LOAD16
#undef CMP_MMA16
#undef CMP_FENCE
#pragma unroll
        for (int rr = 0; rr < 4; ++rr) {
            const int n0 = 32 * wave + 8 * rr + 4 * hi;
            const float v0 = silu_f(acc[4 * rr] + bias[n0]), v1 = silu_f(acc[4 * rr + 1] + bias[n0 + 1]), v2 = silu_f(acc[4 * rr + 2] + bias[n0 + 2]), v3 = silu_f(acc[4 * rr + 3] + bias[n0 + 3]);
            u32x2 w; w.x = cvtpk(v0, v1); w.y = cvtpk(v2, v3);
            *(u32x2*)(hid + r32 * 264 + n0) = w;
        }
        __syncthreads();
        if (wave < 2) {
            f32x16 c2 = z16;
#pragma unroll
            for (int ks = 0; ks < 16; ++ks) {
                const bf16x8 hf = *(const bf16x8*)(hid + r32 * 264 + ks * 16 + hi * 8);
                const bf16x8 wf = *(const bf16x8*)(W2t + (size_t)(32 * wave + r32) * 256 + ks * 16 + hi * 8);
                c2 = X ? __builtin_amdgcn_mfma_f32_32x32x16_bf16(hf, wf, c2, 0, 0, 0) : __builtin_amdgcn_mfma_f32_32x32x16_bf16(wf, hf, c2, 0, 0, 0);
            }
            if (!X) {
                const int kv = i0 + r32; const bool live = kv < 511;
#pragma unroll
                for (int rr = 0; rr < 4; ++rr) {
                    const int d0 = 32 * wave + 8 * rr + 4 * hi;
                    u32x2 w; w.x = cvtpk(c2[4 * rr], c2[4 * rr + 1]); w.y = cvtpk(c2[4 * rr + 2], c2[4 * rr + 3]);
                    if (!live) { w.x = 0u; w.y = 0u; }
                    *(u32x2*)(dst + ktile_off(kv, d0)) = w;
                }
            } else {
                if (i0 == 480 && hi == 1) c2[15] = 0.f;
                const int j = i0 >> 6;
#pragma unroll
                for (int ksl = 0; ksl < 2; ++ksl) {
                    u32x4 w; w.x = cvtpk(c2[8 * ksl], c2[8 * ksl + 1]); w.y = cvtpk(c2[8 * ksl + 2], c2[8 * ksl + 3]); w.z = cvtpk(c2[8 * ksl + 4], c2[8 * ksl + 5]); w.w = cvtpk(c2[8 * ksl + 6], c2[8 * ksl + 7]);
                    *(u32x4*)(dst + (size_t)j * 4096 + (((wave * 4 + 2 * (ch & 1) + ksl) * 64 + lane) << 3)) = w;
                }
            }
        }
    }
}

#define GAS __attribute__((address_space(1)))
#define LAS __attribute__((address_space(3)))
#define XB_TMO      128
#define XB_XCNT(j)  (256  + 64 * (j))
#define XB_XSUB(j)  (1280 + 64 * (j))
#define XB_XGEN(j)  (2304 + 64 * (j))
#define XB_TOP      3328
#define XB_TOPGEN   3392
#define XCD_BAR_WORDS 3456
#define XB_SPIN_CAP (1u << 18)

__device__ __forceinline__ unsigned xb_ld(unsigned* p)              { return __hip_atomic_load(p, __ATOMIC_RELAXED, __HIP_MEMORY_SCOPE_AGENT); }
__device__ __forceinline__ unsigned xb_add(unsigned* p, unsigned v) { return __hip_atomic_fetch_add(p, v, __ATOMIC_RELAXED, __HIP_MEMORY_SCOPE_AGENT); }
__device__ __forceinline__ unsigned xb_xcc_id() { return (unsigned)__builtin_amdgcn_s_getreg((3 << 11) | 20) & 0xFu; }
#define XB_SPIN(cond, bar) do { unsigned _sp = 0; while (cond) { __builtin_amdgcn_s_sleep(1); \
    if ((++_sp & 255u) == 0u) { if (xb_ld(&(bar)[XB_TMO])) break; if (_sp > XB_SPIN_CAP) { atomicAdd(&(bar)[XB_TMO], 1u); break; } } } } while (0)

struct XcdBarrier {
    unsigned* bar; unsigned x;
    volatile LAS unsigned* st;
};

__device__ __forceinline__ XcdBarrier xcd_barrier_post(unsigned* bar, volatile LAS unsigned* st) {
    XcdBarrier b; b.bar = bar; b.x = xb_xcc_id(); b.st = st;
    if (threadIdx.x == 0) (void)xb_add(&bar[XB_XCNT(b.x)], 1u);
    return b;
}
__device__ __forceinline__ void xcd_barrier_complete(unsigned* bar, unsigned x, unsigned& nloc, unsigned& nx) {
    const unsigned G = gridDim.x * gridDim.y * gridDim.z;
    unsigned sum, cnt, mine, sp = 0u;
    for (;;) {
        sum = 0u; cnt = 0u; mine = 0u;
#pragma unroll
        for (unsigned j = 0; j < 16; ++j) { const unsigned c = xb_ld(&bar[XB_XCNT(j)]); sum += c; cnt += (c > 0u) ? 1u : 0u; mine = (j == x) ? c : mine; }
        if (sum == G) break;
        __builtin_amdgcn_s_sleep(1);
        if ((++sp & 255u) == 0u) { if (xb_ld(&bar[XB_TMO])) break; if (sp > XB_SPIN_CAP) { atomicAdd(&bar[XB_TMO], 1u); break; } }
    }
    nloc = mine > 0u ? mine : 1u; nx = cnt > 0u ? cnt : 1u;
}

__device__ __forceinline__ void xcd_barrier(const XcdBarrier& b) {
    asm volatile("s_waitcnt vmcnt(0)" ::: "memory");
    __syncthreads();
    if (threadIdx.x == 0) {
        unsigned* bar = b.bar;
        __builtin_amdgcn_s_waitcnt(0);
        unsigned nloc = b.st[0], nx = b.st[1];
        if (nloc == 0u) { xcd_barrier_complete(bar, b.x, nloc, nx); b.st[0] = nloc; b.st[1] = nx; }
        const unsigned old = xb_add(&bar[XB_XSUB(b.x)], 1u);
        const unsigned gen = old / nloc;
        if (old + 1u == (gen + 1u) * nloc) {
            __builtin_amdgcn_fence(__ATOMIC_RELEASE, "agent");
            asm volatile("s_waitcnt vmcnt(0)" ::: "memory");
            const unsigned og = xb_add(&bar[XB_TOP], 1u);
            const unsigned tg = og / nx;
            if (og + 1u == (tg + 1u) * nx) xb_add(&bar[XB_TOPGEN], 1u);
            else XB_SPIN(xb_ld(&bar[XB_TOPGEN]) == tg, bar);
            __builtin_amdgcn_fence(__ATOMIC_ACQUIRE, "agent");
            xb_add(&bar[XB_XGEN(b.x)], 1u);
            asm volatile("s_waitcnt vmcnt(0)" ::: "memory");
        } else {
            XB_SPIN(xb_ld(&bar[XB_XGEN(b.x)]) == gen, bar);
            __builtin_amdgcn_fence(__ATOMIC_ACQUIRE, "agent");
            asm volatile("s_waitcnt vmcnt(0)" ::: "memory");
        }
    }
    __syncthreads();
}

__global__ void __launch_bounds__(NTHR) mega(Params P, int lo, int hi) {
    extern __shared__ __attribute__((aligned(16))) unsigned char lds[];
    cg::grid_group grid = cg::this_grid();
#ifndef REPMASK
#define REPMASK 0
#endif
#ifndef PHMASK
#define PHMASK 0xFFFF
#endif
#define IN(k) ((((PHMASK) >> (k)) & 1) && lo <= (k) && (k) < hi)
#define REP(k) (((REPMASK) >> (k)) & 1)
    unsigned* barw = (unsigned*)(P.ws + WS_BAR);
    volatile LAS unsigned* MISC = (volatile LAS unsigned*)((LAS unsigned char*)lds + 131072 + 8192 + 256);
    if (threadIdx.x < 16) MISC[threadIdx.x] = 0u;
    __syncthreads();
    if (hi == -12345) grid.sync();
    XcdBarrier xbar = xcd_barrier_post(barw, MISC);
#define SEAM(k) xcd_barrier(xbar)
    bf16_t* XN = (bf16_t*)(P.ws + WS_XN); bf16_t* BIG = (bf16_t*)(P.ws + WS_BIG); bf16_t* Y = (bf16_t*)(P.ws + WS_Y);
    const float* MOD = (const float*)(P.ws + WS_MOD);
    __attribute__((address_space(3))) unsigned char* glds = (__attribute__((address_space(3))) unsigned char*)lds;
#ifdef XSYNC
#pragma nounroll
    for (int xs = 0; xs < XSYNC; ++xs) grid.sync();
#endif
    if (IN(0)) {
#pragma nounroll
        for (int rep = 0; rep < 1 + REP(0); ++rep) { if (rep) xcd_barrier(xbar); ph_mod_partial(P, lds); ph_weights(P, lds); }
    }
    SEAM(0);
    if (IN(1)) {
#pragma nounroll
        for (int rep = 0; rep < 1 + REP(1); ++rep) { if (rep) xcd_barrier(xbar); ph_norm(P, lds, P.x, P.g_ffn1, 0, true); }
    }
    SEAM(1);
    if (IN(2)) {
#pragma nounroll
        for (int rep = 0; rep < 1 + REP(2); ++rep) { if (rep) xcd_barrier(xbar);
        pg8::Gemm g{XN, (const bf16_t*)(P.ws + WS_W1GU), T, 2 * DFF, DM}; pg8::StaticOrder S; S.init(T, 2 * DFF, (int)gridDim.x, (int)blockIdx.x);
        pg8::EpiSwiglu E{BIG, DFF}; pg8::gemm_phase<pg8::EpiSwiglu, pg8::StaticOrder, true, true>(glds, g, S, E); }
    }
    SEAM(2);
    if (IN(3)) { pg8::Gemm g{BIG, (const bf16_t*)(P.ws + WS_W1D), T, DM, DFF}; pg8::StaticOrder S; S.init(T, DM, (int)gridDim.x, (int)blockIdx.x);
        pg8::EpiResidN E{P.x, P.out, MOD + 2 * DM, 0.5f, XN, P.g_mix, MOD + 4 * DM, (float*)(P.ws + WS_RSS)};
        pg8::gemm_phase<pg8::EpiResidN, pg8::StaticOrder, false, true>(glds, g, S, E);
        ph_bias_gemv(P, (const bf16_t*)(P.ws + WS_WIN), PJ, 3); }
    SEAM(3);
    if (IN(5)) { pg8::Gemm g{XN, (const bf16_t*)(P.ws + WS_WIN), T, PJ, DM}; pg8::StaticOrder S; S.init(T, PJ, (int)gridDim.x, (int)blockIdx.x);
        pg8::EpiBf16N E{BIG, PJ, (const float*)(P.ws + WS_RSS), (const float*)(P.ws + WS_BIAS), PJ}; pg8::gemm_phase<pg8::EpiBf16N, pg8::StaticOrder, true, true>(glds, g, S, E); }
    SEAM(5);
    if (IN(6)) {
#pragma nounroll
        for (int rep = 0; rep < 1 + REP(6); ++rep) { if (rep) xcd_barrier(xbar); ph_post(P); ph_vtiles(P, lds); }
    }
    SEAM(6);
    if (IN(7)) {
#pragma nounroll
        for (int rep = 0; rep < 1 + REP(7); ++rep) { if (rep) xcd_barrier(xbar); ph_compress(P, lds); }
    }
    SEAM(7);
    if (IN(8)) {
#pragma nounroll
        for (int rep = 0; rep < 1 + REP(8); ++rep) { if (rep) xcd_barrier(xbar); ph_attn(P, lds); }
    }
    SEAM(8);
    if (IN(9)) { pg8::Gemm g{Y, (const bf16_t*)(P.ws + WS_WOUT), T, DM, DM}; pg8::StaticOrder S; S.init(T, DM, (int)gridDim.x, (int)blockIdx.x);
        pg8::EpiResidN E{P.out, P.out, MOD + 5 * DM, 1.0f, XN, P.g_ffn2, MOD + 7 * DM, (float*)(P.ws + WS_RSS)};
        pg8::gemm_phase<pg8::EpiResidN, pg8::StaticOrder, false, true>(glds, g, S, E);
        ph_bias_gemv(P, (const bf16_t*)(P.ws + WS_W2GU), 2 * DFF, 6); }
    SEAM(9);
    if (IN(11)) { pg8::Gemm g{XN, (const bf16_t*)(P.ws + WS_W2GU), T, 2 * DFF, DM}; pg8::StaticOrder S; S.init(T, 2 * DFF, (int)gridDim.x, (int)blockIdx.x);
        pg8::EpiSwigluN E{BIG, DFF, (const float*)(P.ws + WS_RSS), (const float*)(P.ws + WS_BIAS), 2 * DFF}; pg8::gemm_phase<pg8::EpiSwigluN, pg8::StaticOrder, true, true>(glds, g, S, E); }
    SEAM(11);
    if (IN(12)) { pg8::Gemm g{BIG, (const bf16_t*)(P.ws + WS_W2D), T, DM, DFF}; pg8::StaticOrder S; S.init(T, DM, (int)gridDim.x, (int)blockIdx.x);
        pg8::EpiResid E{P.out, P.out, MOD + 8 * DM, 0.5f}; pg8::gemm_phase<pg8::EpiResid, pg8::StaticOrder, false, true>(glds, g, S, E); }
    SEAM(12);
    if (IN(13)) ph_final_norm(P);
}
constexpr int NPHASE = 14;

extern "C" void kernel_launch(void* const* d_in, const int* in_sizes, int n_in, void* d_out, int out_size, void* d_ws, size_t ws_size, hipStream_t stream) {
    static int grid = 0;
    if (grid == 0) {
        int dev = 0, cus = 0, per_cu = 0;
        hipGetDevice(&dev);
        hipDeviceGetAttribute(&cus, hipDeviceAttributeMultiprocessorCount, dev);
        hipFuncSetAttribute((const void*)mega, hipFuncAttributeMaxDynamicSharedMemorySize, LDS_BYTES);
        hipOccupancyMaxActiveBlocksPerMultiprocessor(&per_cu, (const void*)mega, NTHR, LDS_BYTES);
        if (per_cu < 1) { fprintf(stderr, "kernel_launch: occupancy query reports %d blocks per CU\n", per_cu); per_cu = 1; }
        grid = cus * per_cu;
        (void)hipGetLastError();
    }
    (void)hipMemsetAsync((unsigned char*)d_ws + WS_BAR, 0, 4096 * 4 + 1024, stream);
    Params p{};
    const void** pp = (const void**)&p;
    for (int i = 0; i < 26; ++i) pp[i] = d_in[i];
    p.out = (float*)d_out; p.ws = (unsigned char*)d_ws;
    int lo = 0, hi = NPHASE;
    void* args[] = {&p, &lo, &hi};
    hipError_t e = hipLaunchCooperativeKernel((const void*)mega, dim3(grid), dim3(NTHR), args, LDS_BYTES, stream);
    if (e != hipSuccess) fprintf(stderr, "cooperative launch failed: %s (grid %d)\n", hipGetErrorString(e), grid);
}
```

```cpp
#include <hip/hip_runtime.h>
#include <hip/hip_cooperative_groups.h>
#include <cstdio>
#include <cstdint>
namespace cg = cooperative_groups;

typedef unsigned short bf16_t;
typedef float f32x4 __attribute__((ext_vector_type(4)));
typedef unsigned u32x4 __attribute__((ext_vector_type(4)));
typedef unsigned u32x2 __attribute__((ext_vector_type(2)));

constexpr int NB = 2, SEQ = 8192, DM = 1024, T = NB * SEQ, DFF = 2816, INW = 2840, PJ = 3072;
constexpr int NMODC = 9 * DM;
constexpr float EPS = 1e-6f;
constexpr float QSCALE = 0.125f * 1.4426950408889634f;
constexpr int NTHR = 512, NWV = 8;
constexpr int LDS_BYTES = 147456;
constexpr float NEGV = -1e30f, BIGV = 1e9f;
constexpr int C_CB = 0, C_CC = 512, C_CX = 1024, C_Q = 1536, C_KV = 2048, C_GT = 2816;

constexpr size_t MiB = 1u << 20;
constexpr size_t WS_MODP = 0, WS_MOD = 2 * MiB, WS_B1P = 3 * MiB  , WS_BAR = 3 * MiB + 262144  , WS_XN = 4 * MiB, WS_Y = 36 * MiB, WS_BIG = 68 * MiB, WS_Q = 164 * MiB,
                 WS_KV = 180 * MiB  , WS_KCC = 204 * MiB, WS_VCC = 205 * MiB,
                 WS_W1GU = 206 * MiB, WS_W1D = 217 * MiB, WS_W2GU = 223 * MiB, WS_W2D = 234 * MiB, WS_WIN = 240 * MiB, WS_WOUT = 246 * MiB,
                 WS_WC1K = 248 * MiB, WS_WC1V = 249 * MiB, WS_WC2K = 250 * MiB, WS_WC2V = 250 * MiB + 65536, WS_RSS = 251 * MiB  , WS_BIAS = 252 * MiB  , WS_END = 253 * MiB;

struct Params {
    const float* x; const float* c; const int* pos; const float* w_ada; const float* b_ada; const float* g_ffn1;
    const float* w1g; const float* w1u; const float* w1d; const float* g_mix; const float* w_in; const float* conv_w;
    const float* cpk; const float* cpv; const float* wck1; const float* wck2; const float* wcv1; const float* wcv2;
    const float* goc; const float* goa; const float* w_out; const float* g_ffn2; const float* w2g; const float* w2u;
    const float* w2d; const float* g_final;
    float* out; unsigned char* ws;
};

__device__ __forceinline__ unsigned f2bf(float f) { unsigned u = __float_as_uint(f); return (u + 0x7fffu + ((u >> 16) & 1u)) >> 16; }
__device__ __forceinline__ float bf2f(unsigned v) { return __uint_as_float(v << 16); }
__device__ __forceinline__ unsigned pk2(float lo, float hi) { return f2bf(lo) | (f2bf(hi) << 16); }
__device__ __forceinline__ void ld8(const bf16_t* p, float (&v)[8]) {
    const u32x4 w = *(const u32x4*)p;
    v[0] = bf2f(w.x & 0xffffu); v[1] = bf2f(w.x >> 16); v[2] = bf2f(w.y & 0xffffu); v[3] = bf2f(w.y >> 16);
    v[4] = bf2f(w.z & 0xffffu); v[5] = bf2f(w.z >> 16); v[6] = bf2f(w.w & 0xffffu); v[7] = bf2f(w.w >> 16);
}
__device__ __forceinline__ void st8(bf16_t* p, const float (&v)[8]) {
    u32x4 w; w.x = pk2(v[0], v[1]); w.y = pk2(v[2], v[3]); w.z = pk2(v[4], v[5]); w.w = pk2(v[6], v[7]);
    *(u32x4*)p = w;
}
__device__ __forceinline__ float wave_sum(float v) {
#pragma unroll
    for (int o = 1; o < 64; o <<= 1) v += __shfl_xor(v, o);
    return v;
}
__device__ __forceinline__ float wave_max(float v) {
#pragma unroll
    for (int o = 1; o < 64; o <<= 1) v = fmaxf(v, __shfl_xor(v, o));
    return v;
}
__device__ __forceinline__ float silu_f(float v) { return v / (1.0f + expf(-v)); }
__device__ __forceinline__ unsigned xcc_id_hw() { return (unsigned)__builtin_amdgcn_s_getreg((3 << 11) | 20) & 0xFu; }
#define WSYNC() do { asm volatile("s_waitcnt lgkmcnt(0)" ::: "memory"); __builtin_amdgcn_wave_barrier(); } while (0)

namespace pg8 {
#define PG8_LAS __attribute__((address_space(3)))
typedef unsigned short bf16_t;
typedef short bf16x8 __attribute__((ext_vector_type(8)));
typedef float f32x4 __attribute__((ext_vector_type(4)));
typedef unsigned u32x4 __attribute__((ext_vector_type(4)));
constexpr int BM = 256, BK = 64, HALF = 128, HTB = HALF * BK * 2  , STAGE_BYTES = 8 * HTB, NXCD = 8, WGM = 8;

__host__ __device__ __forceinline__ int lds_byte(int r, int c) { const int st = (r >> 4) * 2 + (c >> 5), rr = r & 15, cc = c & 31, ob = rr * 64 + cc * 2; return st * 1024 + (ob ^ (((ob >> 9) & 1) << 5)); }
__host__ __device__ __forceinline__ void stage_rc(int b, int& R, int& C) { const int st = b / 1024, sb = b % 1024, swz = sb ^ (((sb >> 9) & 1) << 5); R = (st >> 1) * 16 + swz / 64; C = (st & 1) * 32 + (swz % 64) / 2; }
__host__ __device__ __forceinline__ int perm32(int rho) { const int n = rho >> 4, i = rho & 15; return 8 * (i >> 2) + 4 * n + (i & 3); }

struct Unit { int pm, pn; };
struct Gemm { const bf16_t* A; const bf16_t* Bt; int M, N, K; };

struct StaticOrder {
    int nM, nN, nwg, G, c;
    __host__ __device__ void init(int M, int N, int G_, int c_) { nM = M / BM; nN = N / BM; nwg = nM * nN; G = G_; c = c_; }
    __host__ __device__ bool next(int i, Unit& u) const {
        const long L = (long)i * G + c; if (L >= nwg) return false;
        int wgid = (int)L; { const int q = nwg / NXCD, r = nwg % NXCD, xcd = wgid % NXCD, off = wgid / NXCD; wgid = (xcd < r ? xcd * (q + 1) : r * (q + 1) + (xcd - r) * q) + off; }
        const int nig = WGM * nN, gid = wgid / nig, fm = gid * WGM, gsz = (nM - fm) < WGM ? (nM - fm) : WGM;
        u.pm = fm + ((wgid % nig) % gsz); u.pn = (wgid % nig) / gsz; return true;
    }
    __device__ __forceinline__ void a_ready(const Unit&) const {}
    __device__ __forceinline__ void done(const Unit&) const {}
};

__device__ __forceinline__ unsigned cvt_pk_bf16(float lo, float hi) { unsigned r; asm volatile("v_cvt_pk_bf16_f32 %0, %1, %2" : "=v"(r) : "v"(lo), "v"(hi)); return r; }
typedef float f32x2 __attribute__((ext_vector_type(2)));

__device__ __forceinline__ float silu_fast(float v) { return v * __builtin_amdgcn_rcpf(1.0f + __expf(-v)); }
struct EpiBf16 {
    static constexpr bool PERM = true, AFTER_DRAIN = false;
    bf16_t* O; int ldc;
    __device__ __forceinline__ void operator()(const f32x4 (&acc)[2][2][4][2], const Unit& u, int wr, int wc, int fr, int fq) const {
        const int row0 = u.pm * BM + wr * 64 + fr, col0 = u.pn * BM + wc * 32 + 8 * fq;
#pragma unroll
        for (int ai = 0; ai < 2; ++ai)
#pragma unroll
            for (int m = 0; m < 4; ++m) { bf16_t* rowp = O + (size_t)(row0 + ai * HALF + m * 16) * ldc + col0;
#pragma unroll
                for (int bj = 0; bj < 2; ++bj) { const f32x4 v0 = acc[ai][bj][m][0], v1 = acc[ai][bj][m][1];
                    u32x4 w; w.x = cvt_pk_bf16(v0[0], v0[1]); w.y = cvt_pk_bf16(v0[2], v0[3]); w.z = cvt_pk_bf16(v1[0], v1[1]); w.w = cvt_pk_bf16(v1[2], v1[3]);
                    *(u32x4*)(rowp + bj * HALF) = w; } }
    }
};
struct EpiSwiglu {
    static constexpr bool PERM = true, AFTER_DRAIN = false;
    bf16_t* O; int ldc;
    __device__ __forceinline__ void operator()(const f32x4 (&acc)[2][2][4][2], const Unit& u, int wr, int wc, int fr, int fq) const {
        const int row0 = u.pm * BM + wr * 64 + fr, col0 = u.pn * HALF + wc * 32 + 8 * fq;
#pragma unroll
        for (int ai = 0; ai < 2; ++ai)
#pragma unroll
            for (int m = 0; m < 4; ++m) { bf16_t* rowp = O + (size_t)(row0 + ai * HALF + m * 16) * ldc + col0;
                const f32x4 g0 = acc[ai][0][m][0], g1 = acc[ai][0][m][1], u0 = acc[ai][1][m][0], u1 = acc[ai][1][m][1];
                u32x4 w;
                w.x = cvt_pk_bf16(silu_fast(g0[0]) * u0[0], silu_fast(g0[1]) * u0[1]); w.y = cvt_pk_bf16(silu_fast(g0[2]) * u0[2], silu_fast(g0[3]) * u0[3]);
                w.z = cvt_pk_bf16(silu_fast(g1[0]) * u1[0], silu_fast(g1[1]) * u1[1]); w.w = cvt_pk_bf16(silu_fast(g1[2]) * u1[2], silu_fast(g1[3]) * u1[3]);
                *(u32x4*)rowp = w; }
    }
};
struct EpiResid {
    static constexpr bool PERM = false, AFTER_DRAIN = false;
    const float* base; float* out; const float* gate; float gs;
    __device__ __forceinline__ void operator()(const f32x4 (&acc)[2][2][4][2], const Unit& u, int wr, int wc, int fr, int fq) const {
        const int row0 = u.pm * BM + wr * 64 + fr, col0 = u.pn * BM + wc * 32 + 4 * fq;
        const float* gp = gate + (size_t)(u.pm / 32) * 9216;
#pragma unroll
        for (int bj = 0; bj < 2; ++bj)
#pragma unroll
            for (int n = 0; n < 2; ++n) { const int c = col0 + bj * HALF + n * 16; const f32x4 gt = *(const f32x4*)(gp + c) * gs;
#pragma unroll
                for (int ai = 0; ai < 2; ++ai)
#pragma unroll
                    for (int m = 0; m < 4; ++m) { const size_t off = (size_t)(row0 + ai * HALF + m * 16) * 1024 + c;
                        *(f32x4*)(out + off) = *(const f32x4*)(base + off) + gt * acc[ai][bj][m][n]; } }
    }
};

struct EpiResidN {
    static constexpr bool PERM = false, AFTER_DRAIN = false;
    const float* base; float* out; const float* gate; float gs; bf16_t* xn; const float* gnorm; const float* scale; float* rss;
    __device__ __forceinline__ void operator()(const f32x4 (&acc)[2][2][4][2], const Unit& u, int wr, int wc, int fr, int fq) const {
        const int row0 = u.pm * BM + wr * 64 + fr, col0 = u.pn * BM + wc * 32 + 4 * fq;
        const float* gp = gate + (size_t)(u.pm / 32) * 9216 + col0; const float* sp = scale + (size_t)(u.pm / 32) * 9216 + col0; const float* np = gnorm + col0;
#pragma unroll
        for (int ai = 0; ai < 2; ++ai)
#pragma unroll
            for (int m = 0; m < 4; ++m) {
                const int row = row0 + ai * HALF + m * 16; float ss = 0.f;
#pragma unroll
                for (int bj = 0; bj < 2; ++bj)
#pragma unroll
                    for (int n = 0; n < 2; ++n) { const int cl = bj * HALF + n * 16;
                        const f32x4 gt = *(const f32x4*)(gp + cl) * gs, gsv = *(const f32x4*)(np + cl) * (*(const f32x4*)(sp + cl) + 1.0f);
                        const unsigned off = (unsigned)(row * 1024 + col0 + cl);
                        const f32x4 o = *(const f32x4*)(base + off) + gt * acc[ai][bj][m][n];
                        *(f32x4*)(out + off) = o;
                        ss += (o[0] * o[0] + o[1] * o[1]) + (o[2] * o[2] + o[3] * o[3]);
                        const f32x4 h = o * gsv;
                        u32x2 w; w.x = cvt_pk_bf16(h[0], h[1]); w.y = cvt_pk_bf16(h[2], h[3]);
                        *(u32x2*)(xn + off) = w; }
                ss += __shfl_xor(ss, 16); ss += __shfl_xor(ss, 32);
                if (fq == 0) rss[(unsigned)(row * 16 + u.pn * 4 + wc)] = ss;
                if (m & 1) asm volatile("" ::: "memory");
            }
    }
};
__device__ __forceinline__ float row_rstd(const float* rss, int row) {
    const f32x4* p = (const f32x4*)(rss + (size_t)row * 16);
    const f32x4 a = p[0], b = p[1], c = p[2], d = p[3];
    const float s = ((a[0] + a[1]) + (a[2] + a[3])) + ((b[0] + b[1]) + (b[2] + b[3])) + ((c[0] + c[1]) + (c[2] + c[3])) + ((d[0] + d[1]) + (d[2] + d[3]));
    return 1.0f / sqrtf(s * (1.0f / 1024.0f) + 1e-6f);
}
struct EpiBf16N {
    static constexpr bool PERM = true, AFTER_DRAIN = false;
    bf16_t* O; int ldc; const float* rss; const float* bias; int nbias;
    __device__ __forceinline__ void operator()(const f32x4 (&acc)[2][2][4][2], const Unit& u, int wr, int wc, int fr, int fq) const {
        const int row0 = u.pm * BM + wr * 64 + fr, col0 = u.pn * BM + wc * 32 + 8 * fq;
        const float* bp = bias + (size_t)(u.pm / 32) * nbias + col0;
        f32x4 bv[2][2];
#pragma unroll
        for (int bj = 0; bj < 2; ++bj)
#pragma unroll
            for (int n = 0; n < 2; ++n) bv[bj][n] = *(const f32x4*)(bp + bj * HALF + 4 * n);
#pragma unroll
        for (int ai = 0; ai < 2; ++ai)
#pragma unroll
            for (int m = 0; m < 4; ++m) { const int row = row0 + ai * HALF + m * 16; const float rs = row_rstd(rss, row); bf16_t* rowp = O + (size_t)row * ldc + col0;
#pragma unroll
                for (int bj = 0; bj < 2; ++bj) { const f32x4 v0 = acc[ai][bj][m][0] * rs + bv[bj][0], v1 = acc[ai][bj][m][1] * rs + bv[bj][1];
                    u32x4 w; w.x = cvt_pk_bf16(v0[0], v0[1]); w.y = cvt_pk_bf16(v0[2], v0[3]); w.z = cvt_pk_bf16(v1[0], v1[1]); w.w = cvt_pk_bf16(v1[2], v1[3]);
                    *(u32x4*)(rowp + bj * HALF) = w; } }
    }
};
struct EpiSwigluN {
    static constexpr bool PERM = true, AFTER_DRAIN = false;
    bf16_t* O; int ldc; const float* rss; const float* bias; int nbias;
    __device__ __forceinline__ void operator()(const f32x4 (&acc)[2][2][4][2], const Unit& u, int wr, int wc, int fr, int fq) const {
        const int row0 = u.pm * BM + wr * 64 + fr, col0 = u.pn * HALF + wc * 32 + 8 * fq;
        const float* bp = bias + (size_t)(u.pm / 32) * nbias + u.pn * BM + wc * 32 + 8 * fq;
        const f32x4 bg0 = *(const f32x4*)(bp), bg1 = *(const f32x4*)(bp + 4), bu0 = *(const f32x4*)(bp + HALF), bu1 = *(const f32x4*)(bp + HALF + 4);
#pragma unroll
        for (int ai = 0; ai < 2; ++ai)
#pragma unroll
            for (int m = 0; m < 4; ++m) { const int row = row0 + ai * HALF + m * 16; const float rs = row_rstd(rss, row); bf16_t* rowp = O + (size_t)row * ldc + col0;
                const f32x4 g0 = acc[ai][0][m][0] * rs + bg0, g1 = acc[ai][0][m][1] * rs + bg1, u0 = acc[ai][1][m][0] * rs + bu0, u1 = acc[ai][1][m][1] * rs + bu1;
                u32x4 w;
                w.x = cvt_pk_bf16(silu_fast(g0[0]) * u0[0], silu_fast(g0[1]) * u0[1]); w.y = cvt_pk_bf16(silu_fast(g0[2]) * u0[2], silu_fast(g0[3]) * u0[3]);
                w.z = cvt_pk_bf16(silu_fast(g1[0]) * u1[0], silu_fast(g1[1]) * u1[1]); w.w = cvt_pk_bf16(silu_fast(g1[2]) * u1[2], silu_fast(g1[3]) * u1[3]);
                *(u32x4*)rowp = w; }
    }
};
template <class Epi, class Sched, bool ALIGN_EPI = false, bool SP2 = false>
__device__ __forceinline__ void gemm_phase(PG8_LAS unsigned char* lds, const Gemm g, const Sched& S, const Epi& E) {
    const int tid = threadIdx.x, wid = __builtin_amdgcn_readfirstlane(tid >> 6), lane = tid & 63, wr = wid >> 2, wc = wid & 3, fr = lane & 15, fq = lane >> 4;
    const int K = g.K, nt = K / BK;
    unsigned voffA[2], voffB[2];
#pragma unroll
    for (int i = 0; i < 2; ++i) { int R, C; stage_rc(tid * 16 + i * 8192, R, C); const int Rb = Epi::PERM ? ((R & ~31) + perm32(R & 31)) : R;
        voffA[i] = (unsigned)(R * K + C) * 2u; voffB[i] = (unsigned)(Rb * K + C) * 2u; }
    const size_t kstep = (size_t)(BK * 2);
    const size_t hstep = (size_t)HALF * K * 2;
    const size_t tstep = 2 * hstep;
    const unsigned ldsw = (unsigned)wid * 1024u;
    const int aoff = lds_byte(wr * 64 + fr, fq * 8), boff = lds_byte(wc * 32 + fr, fq * 8);
#define PG8_SA(b, h) (((b) * 2 + (h)) * HTB)
#define PG8_SB(b, h) ((4 + (b) * 2 + (h)) * HTB)
#define PG8_STAGE(bufoff, gbase, voff) do { _Pragma("unroll") for (int _i = 0; _i < 2; ++_i) \
        __builtin_amdgcn_global_load_lds((const unsigned*)((const char*)(gbase) + (voff)[_i]), (PG8_LAS unsigned*)(lds + (bufoff) + ldsw + _i * 8192), 16, 0, 0); } while (0)
#define PG8_LDA(dst, b, h) do { _Pragma("unroll") for (int m = 0; m < 4; ++m) _Pragma("unroll") for (int k = 0; k < 2; ++k) dst[m][k] = *(const PG8_LAS bf16x8*)(lds + PG8_SA(b, h) + aoff + m * 2048 + k * 1024); } while (0)
#define PG8_LDB(dst, b, h) do { _Pragma("unroll") for (int n = 0; n < 2; ++n) _Pragma("unroll") for (int k = 0; k < 2; ++k) dst[n][k] = *(const PG8_LAS bf16x8*)(lds + PG8_SB(b, h) + boff + n * 2048 + k * 1024); } while (0)
#define PG8_MMA(ai, bj, At, Bt) do { __builtin_amdgcn_s_setprio(1); _Pragma("unroll") for (int m = 0; m < 4; ++m) _Pragma("unroll") for (int n = 0; n < 2; ++n) _Pragma("unroll") for (int k = 0; k < 2; ++k) \
        acc[ai][bj][m][n] = __builtin_amdgcn_mfma_f32_16x16x32_bf16(Bt[n][k], At[m][k], acc[ai][bj][m][n], 0, 0, 0); __builtin_amdgcn_s_setprio(0); } while (0)
#define PG8_WAIT_V(n) asm volatile("s_waitcnt vmcnt(" #n ")" ::: "memory")
#define PG8_WAIT_L(n) asm volatile("s_waitcnt lgkmcnt(" #n ")" ::: "memory")
#define PG8_BAR __builtin_amdgcn_s_barrier()
#define PG8_SCHED __builtin_amdgcn_sched_barrier(0)
    Unit cur, nxt; int ui = 0;
    if (!S.next(0, cur)) return;
    f32x4 acc[2][2][4][2];
#pragma unroll
    for (int a = 0; a < 2; ++a)
#pragma unroll
        for (int b = 0; b < 2; ++b)
#pragma unroll
            for (int m = 0; m < 4; ++m)
#pragma unroll
                for (int n = 0; n < 2; ++n) acc[a][b][m][n] = (f32x4){0.f, 0.f, 0.f, 0.f};
    bf16x8 At[4][2], B0[2][2], B1[2][2];
    const char* cA = (const char*)g.A + (size_t)cur.pm * tstep; const char* cB = (const char*)g.Bt + (size_t)cur.pn * tstep;
    S.a_ready(cur);
    if constexpr (SP2) {
        PG8_STAGE(PG8_SB(0, 0), cB, voffB); PG8_STAGE(PG8_SB(0, 1), cB + hstep, voffB); PG8_STAGE(PG8_SA(0, 0), cA, voffA); PG8_STAGE(PG8_SA(0, 1), cA + hstep, voffA);
        if (wr == 1) PG8_BAR;
        PG8_WAIT_V(2); PG8_BAR;
        PG8_STAGE(PG8_SB(1, 0), cB + kstep, voffB); PG8_STAGE(PG8_SA(1, 0), cA + kstep, voffA); PG8_STAGE(PG8_SB(1, 1), cB + hstep + kstep, voffB);
        PG8_WAIT_V(6); PG8_BAR;
    } else {
        PG8_STAGE(PG8_SB(0, 0), cB, voffB); PG8_STAGE(PG8_SA(0, 0), cA, voffA); PG8_STAGE(PG8_SB(0, 1), cB + hstep, voffB); PG8_STAGE(PG8_SA(0, 1), cA + hstep, voffA);
        if (wr == 1) PG8_BAR;
        PG8_WAIT_V(4); PG8_BAR;
        PG8_STAGE(PG8_SB(1, 0), cB + kstep, voffB); PG8_STAGE(PG8_SA(1, 0), cA + kstep, voffA); PG8_STAGE(PG8_SB(1, 1), cB + hstep + kstep, voffB);
        PG8_WAIT_V(6); PG8_BAR;
    }
    for (;;) {
        const bool has_next = S.next(ui + 1, nxt);
        const char* nA = has_next ? (const char*)g.A + (size_t)nxt.pm * tstep : cA; const char* nB = has_next ? (const char*)g.Bt + (size_t)nxt.pn * tstep : cB;
        for (int t = 0; t < nt; t += 2) {
            const bool last = (t == nt - 2);
            const char* a1 = cA + (size_t)(t + 1) * kstep;
            const char* a2 = last ? nA : cA + (size_t)(t + 2) * kstep; const char* b2 = last ? nB : cB + (size_t)(t + 2) * kstep;
            const char* a3 = a2 + kstep; const char* b3 = b2 + kstep;
            if (last && has_next) S.a_ready(nxt);
            if constexpr (SP2) {
            PG8_LDB(B0, 0, 0); PG8_LDB(B1, 0, 1); PG8_SCHED; PG8_LDA(At, 0, 0); PG8_STAGE(PG8_SA(1, 1), a1 + hstep, voffA);
            PG8_WAIT_V(8); PG8_WAIT_L(0); PG8_BAR; PG8_MMA(0, 0, At, B0); PG8_MMA(0, 1, At, B1); PG8_BAR; PG8_SCHED;
            PG8_LDA(At, 0, 1); PG8_STAGE(PG8_SB(0, 0), b2, voffB); PG8_STAGE(PG8_SB(0, 1), b2 + hstep, voffB); PG8_STAGE(PG8_SA(0, 0), a2, voffA);
            PG8_WAIT_V(8); PG8_WAIT_L(0); PG8_BAR; PG8_MMA(1, 0, At, B0); PG8_MMA(1, 1, At, B1); PG8_BAR; PG8_SCHED;
            PG8_LDB(B0, 1, 0); PG8_LDB(B1, 1, 1); PG8_SCHED; PG8_LDA(At, 1, 0); PG8_STAGE(PG8_SA(0, 1), a2 + hstep, voffA);
            PG8_WAIT_V(8); PG8_WAIT_L(0); PG8_BAR; PG8_MMA(0, 0, At, B0); PG8_MMA(0, 1, At, B1); PG8_BAR; PG8_SCHED;
            PG8_LDA(At, 1, 1); PG8_STAGE(PG8_SB(1, 0), b3, voffB); PG8_STAGE(PG8_SB(1, 1), b3 + hstep, voffB); PG8_STAGE(PG8_SA(1, 0), a3, voffA);
            PG8_WAIT_V(8); PG8_WAIT_L(0); PG8_BAR; PG8_MMA(1, 0, At, B0); PG8_MMA(1, 1, At, B1); PG8_BAR; PG8_SCHED;
            } else {
            PG8_LDB(B0, 0, 0); PG8_SCHED; PG8_LDA(At, 0, 0); PG8_STAGE(PG8_SA(1, 1), a1 + hstep, voffA);
            PG8_WAIT_L(8); PG8_BAR; PG8_WAIT_L(0); PG8_MMA(0, 0, At, B0); PG8_BAR; PG8_SCHED;
            PG8_LDB(B1, 0, 1); PG8_STAGE(PG8_SB(0, 0), b2, voffB);
            PG8_BAR; PG8_WAIT_L(0); PG8_MMA(0, 1, At, B1); PG8_BAR;
            PG8_LDA(At, 0, 1); PG8_STAGE(PG8_SA(0, 0), a2, voffA);
            PG8_BAR; PG8_WAIT_L(0); PG8_MMA(1, 0, At, B0); PG8_BAR; PG8_SCHED;
            PG8_STAGE(PG8_SB(0, 1), b2 + hstep, voffB);
            PG8_WAIT_V(6); PG8_BAR; PG8_MMA(1, 1, At, B1); PG8_BAR;
            PG8_LDB(B0, 1, 0); PG8_SCHED; PG8_LDA(At, 1, 0); PG8_STAGE(PG8_SA(0, 1), a2 + hstep, voffA);
            PG8_WAIT_L(8); PG8_BAR; PG8_WAIT_L(0); PG8_MMA(0, 0, At, B0); PG8_BAR; PG8_SCHED;
            PG8_LDB(B1, 1, 1); PG8_STAGE(PG8_SB(1, 0), b3, voffB);
            PG8_BAR; PG8_WAIT_L(0); PG8_MMA(0, 1, At, B1); PG8_BAR;
            PG8_LDA(At, 1, 1); PG8_STAGE(PG8_SA(1, 0), a3, voffA);
            PG8_BAR; PG8_WAIT_L(0); PG8_MMA(1, 0, At, B0); PG8_BAR; PG8_SCHED;
            PG8_STAGE(PG8_SB(1, 1), b3 + hstep, voffB);
            PG8_WAIT_V(6); PG8_BAR; PG8_MMA(1, 1, At, B1); PG8_BAR;
            }
        }
        if constexpr (ALIGN_EPI) { if (wr == 0) PG8_BAR; }
        if constexpr (!Epi::AFTER_DRAIN) { E(acc, cur, wr, wc, fr, fq); S.done(cur); }
        if (!has_next) break;
#pragma unroll
        for (int a = 0; a < 2; ++a)
#pragma unroll
            for (int b = 0; b < 2; ++b)
#pragma unroll
                for (int m = 0; m < 4; ++m)
#pragma unroll
                    for (int n = 0; n < 2; ++n) acc[a][b][m][n] = (f32x4){0.f, 0.f, 0.f, 0.f};
        cur = nxt; cA = nA; cB = nB; ++ui;
        if constexpr (ALIGN_EPI) { if (wr == 1) PG8_BAR; }
    }
    PG8_WAIT_V(0);
    if constexpr (!ALIGN_EPI) { if (wr == 0) PG8_BAR; }
    PG8_BAR;
    if constexpr (Epi::AFTER_DRAIN) { E.fused(acc, cur, wr, wc, fr, fq, lds, wid, lane); S.done(cur); }
#undef PG8_SA
#undef PG8_SB
#undef PG8_STAGE
#undef PG8_LDA
#undef PG8_LDB
#undef PG8_MMA
#undef PG8_WAIT_V
#undef PG8_WAIT_L
#undef PG8_BAR
#undef PG8_SCHED
}
}

__device__ __forceinline__ void ph_mod_partial(const Params& P, unsigned char* lds) {
    const int lane = threadIdx.x & 63, wave = __builtin_amdgcn_readfirstlane(threadIdx.x >> 6);
    const int gw = blockIdx.x * NWV + wave, NGW = gridDim.x * NWV;
    float* modp = (float*)(P.ws + WS_MODP);
    float* ca = (float*)(lds + 131072);
    for (int e = threadIdx.x; e < 2 * DM; e += NTHR) ca[e] = silu_f(P.c[e]);
    __syncthreads();
    for (int it = gw; it < 144 * 16; it += NGW) {
        const int cgp = it % 144, ks = it / 144, n = cgp * 64 + lane;
        float a0 = 0.f, a1 = 0.f;
        const float* wp = P.w_ada + (size_t)(ks * 64) * NMODC + n;
#pragma unroll 16
        for (int kk = 0; kk < 64; ++kk) {
            const float w = wp[(size_t)kk * NMODC];
            a0 += ca[ks * 64 + kk] * w; a1 += ca[DM + ks * 64 + kk] * w;
        }
        modp[(size_t)(ks * 2 + 0) * NMODC + n] = a0; modp[(size_t)(ks * 2 + 1) * NMODC + n] = a1;
    }
}

template <bool FRAG = false>
__device__ __forceinline__ void tr_item(const float* W, int K, int N, bf16_t* WT, int dest_row0, float* scr, int k0, int n0, int lane) {
    const int nn = n0 + (lane & 31); const bool ok = nn < N;
#pragma unroll
    for (int i = 0; i < 32; ++i) { const int kk = 2 * i + (lane >> 5); scr[kk * 33 + (lane & 31)] = ok ? W[(size_t)(k0 + kk) * N + nn] : 0.f; }
    WSYNC();
    const int c = lane & 7;
#pragma unroll
    for (int j = 0; j < 4; ++j) { const int n = (lane >> 3) + 8 * j; const float* sp = scr + (8 * c) * 33 + n;
        u32x4 o; o.x = pk2(sp[0 * 33], sp[1 * 33]); o.y = pk2(sp[2 * 33], sp[3 * 33]); o.z = pk2(sp[4 * 33], sp[5 * 33]); o.w = pk2(sp[6 * 33], sp[7 * 33]);
        if (FRAG) { const int nn2 = dest_row0 + n, kk2 = k0 + 8 * c;
            *(u32x4*)(WT + ((size_t)(((nn2 >> 5) * (K >> 4) + (kk2 >> 4)) * 64 + ((kk2 >> 3) & 1) * 32 + (nn2 & 31)) << 3)) = o; }
        else *(u32x4*)(WT + (size_t)(dest_row0 + n) * K + k0 + 8 * c) = o; }
    WSYNC();
}
__device__ __forceinline__ void ph_weights(const Params& P, unsigned char* lds) {
    const int lane = threadIdx.x & 63, wave = __builtin_amdgcn_readfirstlane(threadIdx.x >> 6);
    const int gw = blockIdx.x * NWV + wave, NGW = gridDim.x * NWV;
    float* scr = (float*)(lds + wave * 16384);
    constexpr int I_GU = 16 * 88, I_D = 44 * 32, I_IN = 16 * 96, I_OUT = 16 * 32, I_C1 = 32 * 8, I_C2 = 4 * 2, I_B1 = 2 * 32 * 4;
    constexpr int NIT = 4 * I_GU + 2 * I_D + I_IN + I_OUT + 2 * I_C1 + 2 * I_C2 + I_B1;
    for (int it = gw; it < NIT; it += NGW) {
        int r = it;
        if (r < 4 * I_GU) {
            const int w = r / I_GU; r -= w * I_GU; const int kb = r / 88, nb = r % 88, n0 = nb * 32;
            const float* W = (w == 0) ? P.w1g : (w == 1) ? P.w1u : (w == 2) ? P.w2g : P.w2u;
            bf16_t* WT = (bf16_t*)(P.ws + ((w < 2) ? WS_W1GU : WS_W2GU));
            tr_item(W, DM, DFF, WT, 256 * (n0 >> 7) + (n0 & 127) + ((w & 1) ? 128 : 0), scr, kb * 64, n0, lane);
            continue;
        }
        r -= 4 * I_GU;
        if (r < 2 * I_D) {
            const int w = r / I_D; r -= w * I_D; const int kb = r / 32, nb = r % 32;
            tr_item(w ? P.w2d : P.w1d, DFF, DM, (bf16_t*)(P.ws + (w ? WS_W2D : WS_W1D)), nb * 32, scr, kb * 64, nb * 32, lane);
            continue;
        }
        r -= 2 * I_D;
        if (r < I_IN) { const int kb = r / 96, nb = r % 96; tr_item(P.w_in, DM, INW, (bf16_t*)(P.ws + WS_WIN), nb * 32, scr, kb * 64, nb * 32, lane); continue; }
        r -= I_IN;
        if (r < I_OUT) { const int kb = r / 32, nb = r % 32; tr_item(P.w_out, DM, DM, (bf16_t*)(P.ws + WS_WOUT), nb * 32, scr, kb * 64, nb * 32, lane); continue; }
        r -= I_OUT;
        if (r < 2 * I_C1) { const int X = r / I_C1; r -= X * I_C1; const int kb = r / 8, nb = r % 8;
            tr_item<true>(X ? P.wcv1 : P.wck1, 2048, 256, (bf16_t*)(P.ws + (X ? WS_WC1V : WS_WC1K)), nb * 32, scr, kb * 64, nb * 32, lane); continue; }
        r -= 2 * I_C1;
        if (r < 2 * I_C2) { const int X = r / I_C2; r -= X * I_C2; const int kb = r / 2, nb = r % 2;
            tr_item(X ? P.wcv2 : P.wck2, 256, 64, (bf16_t*)(P.ws + (X ? WS_WC2V : WS_WC2K)), nb * 32, scr, kb * 64, nb * 32, lane); continue; }
        r -= 2 * I_C2;
        {
            const int X = r >> 7, ks = (r >> 2) & 31, n = (r & 3) * 64 + lane;
            const float* W1 = X ? P.wcv1 : P.wck1; const float* pe = X ? P.cpv : P.cpk;
            float a = 0.f;
            for (int kk = 0; kk < 64; ++kk) { const int k = ks * 64 + kk; a += pe[k] * W1[(size_t)k * 256 + n]; }
            ((float*)(P.ws + WS_B1P))[(X * 32 + ks) * 256 + n] = a;
        }
    }
}

__device__ __forceinline__ void ph_bias_gemv(const Params& P, const bf16_t* Wt, int N, int idx_shift) {
    const int lane = threadIdx.x & 63, wave = __builtin_amdgcn_readfirstlane(threadIdx.x >> 6);
    const int gw = blockIdx.x * NWV + wave, NGW = gridDim.x * NWV;
    const float* mod = (const float*)(P.ws + WS_MOD);
    float* bias = (float*)(P.ws + WS_BIAS);
    float s0[16], s1[16];
#pragma unroll
    for (int q = 0; q < 4; ++q) { const f32x4 a = *(const f32x4*)(mod + idx_shift * DM + lane * 16 + q * 4), b = *(const f32x4*)(mod + NMODC + idx_shift * DM + lane * 16 + q * 4);
        s0[4 * q] = a[0]; s0[4 * q + 1] = a[1]; s0[4 * q + 2] = a[2]; s0[4 * q + 3] = a[3]; s1[4 * q] = b[0]; s1[4 * q + 1] = b[1]; s1[4 * q + 2] = b[2]; s1[4 * q + 3] = b[3]; }
    for (int n = gw; n < N; n += NGW) {
        float w[16]; { float t[8]; ld8(Wt + (size_t)n * DM + lane * 16, t);
#pragma unroll
            for (int e2 = 0; e2 < 8; ++e2) w[e2] = t[e2];
            ld8(Wt + (size_t)n * DM + lane * 16 + 8, t);
#pragma unroll
            for (int e2 = 0; e2 < 8; ++e2) w[8 + e2] = t[e2]; }
        float a0 = 0.f, a1 = 0.f;
#pragma unroll
        for (int e2 = 0; e2 < 16; ++e2) { a0 += s0[e2] * w[e2]; a1 += s1[e2] * w[e2]; }
        a0 = wave_sum(a0); a1 = wave_sum(a1);
        if (lane == 0) { bias[n] = a0; bias[N + n] = a1; }
    }
}
__device__ __forceinline__ void ph_norm(const Params& P, unsigned char* lds, const float* src, const float* g, int idx_shift, bool from_partials) {
    const int tid = threadIdx.x, lane = tid & 63, wave = __builtin_amdgcn_readfirstlane(tid >> 6);
    float* sh = (float*)lds;
    const float* modp = (const float*)(P.ws + WS_MODP);
    float* mod = (float*)(P.ws + WS_MOD);
    bf16_t* dst = (bf16_t*)(P.ws + WS_XN);
    if (from_partials) {
        for (int e = blockIdx.x * NTHR + tid; e < 2 * NMODC; e += gridDim.x * NTHR) {
            const int b = e / NMODC, n = e % NMODC; float v = P.b_ada[n];
            for (int ks = 0; ks < 16; ++ks) v += modp[(size_t)(ks * 2 + b) * NMODC + n];
            mod[e] = v;
        }
    }
    for (int chunk = blockIdx.x; chunk < 256; chunk += gridDim.x) {
        const int b = chunk / 128;
        __syncthreads();
        for (int ci = tid; ci < 2048; ci += NTHR) {
            const int n = idx_shift * DM + ci; float v;
            if (from_partials) { v = P.b_ada[n]; for (int ks = 0; ks < 16; ++ks) v += modp[(size_t)(ks * 2 + b) * NMODC + n]; }
            else v = mod[b * NMODC + n];
            sh[ci] = v;
        }
        __syncthreads();
        for (int r = 0; r < 8; r += 4) {
            const int row = chunk * 64 + wave * 8 + r;
            f32x4 v[4][4]; float ss[4];
#pragma unroll
            for (int q = 0; q < 4; ++q) { const f32x4* xr = (const f32x4*)(src + (size_t)(row + q) * DM) + lane;
#pragma unroll
                for (int j = 0; j < 4; ++j) v[q][j] = xr[64 * j]; }
#pragma unroll
            for (int q = 0; q < 4; ++q) { float a = 0.f;
#pragma unroll
                for (int j = 0; j < 4; ++j) a += (v[q][j].x * v[q][j].x + v[q][j].y * v[q][j].y) + (v[q][j].z * v[q][j].z + v[q][j].w * v[q][j].w);
                ss[q] = a; }
#pragma unroll
            for (int o2 = 1; o2 < 64; o2 <<= 1) {
#pragma unroll
                for (int q = 0; q < 4; ++q) ss[q] += __shfl_xor(ss[q], o2); }
#pragma unroll
            for (int j = 0; j < 4; ++j) {
                const int col = 256 * j + 4 * lane;
                const f32x4 gg = *(const f32x4*)(g + col), s4 = *(const f32x4*)(sh + col), c4 = *(const f32x4*)(sh + 1024 + col);
                const f32x4 gm = gg * (c4 + 1.0f);
#pragma unroll
                for (int q = 0; q < 4; ++q) {
                    const float rstd = 1.0f / sqrtf(ss[q] * (1.0f / DM) + EPS);
                    const f32x4 o = v[q][j] * rstd * gm + s4;
                    u32x2 w; w.x = pk2(o.x, o.y); w.y = pk2(o.z, o.w);
                    *(u32x2*)(dst + (size_t)(row + q) * DM + col) = w;
                }
            }
        }
    }
}
__device__ __forceinline__ void ph_final_norm(const Params& P) {
    const int lane = threadIdx.x & 63, wave = __builtin_amdgcn_readfirstlane(threadIdx.x >> 6);
    const int gw = blockIdx.x * NWV + wave, NGW = gridDim.x * NWV;
    f32x4 gg[4];
#pragma unroll
    for (int j = 0; j < 4; ++j) gg[j] = *(const f32x4*)(P.g_final + 256 * j + 4 * lane);
    for (int row0 = gw * 4; row0 < T; row0 += NGW * 4) {
        f32x4 v[4][4]; float ss[4];
#pragma unroll
        for (int q = 0; q < 4; ++q) { const f32x4* xr = (const f32x4*)(P.out + (size_t)(row0 + q) * DM) + lane;
#pragma unroll
            for (int j = 0; j < 4; ++j) v[q][j] = xr[64 * j]; }
#pragma unroll
        for (int q = 0; q < 4; ++q) { float a = 0.f;
#pragma unroll
            for (int j = 0; j < 4; ++j) a += (v[q][j].x * v[q][j].x + v[q][j].y * v[q][j].y) + (v[q][j].z * v[q][j].z + v[q][j].w * v[q][j].w);
            ss[q] = a; }
#pragma unroll
        for (int o2 = 1; o2 < 64; o2 <<= 1) {
#pragma unroll
            for (int q = 0; q < 4; ++q) ss[q] += __shfl_xor(ss[q], o2); }
#pragma unroll
        for (int q = 0; q < 4; ++q) { const float rstd = 1.0f / sqrtf(ss[q] * (1.0f / DM) + EPS);
            f32x4* xr = (f32x4*)(P.out + (size_t)(row0 + q) * DM) + lane;
#pragma unroll
            for (int j = 0; j < 4; ++j) xr[64 * j] = v[q][j] * rstd * gg[j]; }
    }
}

__device__ __forceinline__ int ktile_off(int kv, int d) {
    const int j = kv >> 6, kl = kv & 63, mb = kl >> 5, r32 = kl & 31, ds = d >> 4, hi = (d >> 3) & 1, e = d & 7;
    return j * 4096 + (((mb * 4 + ds) * 64 + hi * 32 + r32) << 3) + e;
}
__device__ __forceinline__ int vtile_off(int kv, int d) {
    const int j = kv >> 6, kl = kv & 63, ks = kl >> 4, w = kl & 15, hi = (w >> 2) & 1, e = (w & 3) | ((w >> 3) << 2), d0 = d >> 5, r32 = d & 31;
    return j * 4096 + (((d0 * 4 + ks) * 64 + hi * 32 + r32) << 3) + e;
}
__device__ __forceinline__ void up8(const u32x4 w, float (&v)[8]) {
    v[0] = bf2f(w.x & 0xffffu); v[1] = bf2f(w.x >> 16); v[2] = bf2f(w.y & 0xffffu); v[3] = bf2f(w.y >> 16);
    v[4] = bf2f(w.z & 0xffffu); v[5] = bf2f(w.z >> 16); v[6] = bf2f(w.w & 0xffffu); v[7] = bf2f(w.w >> 16);
}
__device__ __forceinline__ void vtile_item(const Params& P, unsigned char* lds, int it, int lane, int wave);
__device__ __forceinline__ void ph_post(const Params& P, unsigned char* lds) {
    const int lane = threadIdx.x & 63, wave = __builtin_amdgcn_readfirstlane(threadIdx.x >> 6);
    const bf16_t* PROJ = (const bf16_t*)(P.ws + WS_BIG);
    bf16_t* Y = (bf16_t*)(P.ws + WS_Y);
    bf16_t* Qr = (bf16_t*)(P.ws + WS_Q);
    const int ch = lane * 8, chunk = lane & 7;
    float w0[8], w1[8], w2[8], gc[8];
#pragma unroll
    for (int e = 0; e < 8; ++e) { w0[e] = P.conv_w[ch + e]; w1[e] = P.conv_w[512 + ch + e]; w2[e] = P.conv_w[1024 + ch + e]; gc[e] = P.goc[ch + e]; }
    const bool act1 = lane < 32;
    constexpr int CHT = 4, NCH = T / CHT;
    const int G = (int)gridDim.x, ncb = (G < 128) ? G : 128, blk = (int)blockIdx.x;
    const int wgt = (blk < ncb) ? 1 : 3;
    const int cstart = (blk < ncb) ? (blk * NWV + wave) : (ncb * NWV + ((blk - ncb) * NWV + wave) * 3);
    const int cstride = NWV * (ncb + 3 * (G - ncb));
    if (G > ncb) { if (blk >= ncb) for (int v = (blk - ncb) * NWV + wave; v < 1024; v += (G - ncb) * NWV) vtile_item(P, lds, v, lane, wave); }
    else for (int v = blk * NWV + wave; v < 1024; v += G * NWV) vtile_item(P, lds, v, lane, wave);
    for (int c0 = cstart; c0 < NCH; c0 += cstride)
    for (int cc = 0; cc < wgt; ++cc) {
        const int cidx = c0 + cc; if (cidx >= NCH) break;
        const int t0 = cidx * CHT;
        const int b = t0 / SEQ, sb = t0 % SEQ;
        const bf16_t* pr = PROJ + (size_t)t0 * PJ;
        float u1[8], u2[8];
#pragma unroll
        for (int e = 0; e < 8; ++e) { u1[e] = 0.f; u2[e] = 0.f; }
        if (sb >= 2) {
            float c1[8], x1[8], c2[8], x2[8];
            up8(*(const u32x4*)(pr - PJ + C_CC + ch), c1); up8(*(const u32x4*)(pr - PJ + C_CX + ch), x1);
            up8(*(const u32x4*)(pr - 2 * PJ + C_CC + ch), c2); up8(*(const u32x4*)(pr - 2 * PJ + C_CX + ch), x2);
#pragma unroll
            for (int e = 0; e < 8; ++e) { u1[e] = c1[e] * x1[e]; u2[e] = c2[e] * x2[e]; }
        }
        const u32x4 zz = {0u, 0u, 0u, 0u};
        u32x4 rcb = *(const u32x4*)(pr + C_CB + ch), rcc = *(const u32x4*)(pr + C_CC + ch), rcx = *(const u32x4*)(pr + C_CX + ch), rq = *(const u32x4*)(pr + C_Q + ch);
        u32x4 rk0 = *(const u32x4*)(pr + C_KV + ch), rk1 = act1 ? *(const u32x4*)(pr + C_KV + 512 + ch) : zz;
        for (int i = 0; i < CHT; ++i) {
            const int tok = t0 + i, s = sb + i;
            const u32x4 ccb = rcb, ccc = rcc, ccx = rcx, cq = rq, ck0 = rk0, ck1 = rk1;
            if (i < CHT - 1) { const bf16_t* pn = pr + (size_t)(i + 1) * PJ;
                rcb = *(const u32x4*)(pn + C_CB + ch); rcc = *(const u32x4*)(pn + C_CC + ch); rcx = *(const u32x4*)(pn + C_CX + ch); rq = *(const u32x4*)(pn + C_Q + ch);
                rk0 = *(const u32x4*)(pn + C_KV + ch); rk1 = act1 ? *(const u32x4*)(pn + C_KV + 512 + ch) : zz; }
            {
                float cb[8], c0[8], x0[8]; up8(ccb, cb); up8(ccc, c0); up8(ccx, x0);
                float y[8]; float ss = 0.f;
#pragma unroll
                for (int e = 0; e < 8; ++e) {
                    const float u0 = c0[e] * x0[e];
                    const float v = w0[e] * u2[e] + w1[e] * u1[e] + w2[e] * u0;
                    u2[e] = u1[e]; u1[e] = u0;
                    y[e] = cb[e] * v; ss += y[e] * y[e];
                }
                ss += __shfl_xor(ss, 1); ss += __shfl_xor(ss, 2); ss += __shfl_xor(ss, 4);
                const float rstd = 1.0f / sqrtf(ss * (1.0f / 64.0f) + EPS);
#pragma unroll
                for (int e = 0; e < 8; ++e) y[e] = y[e] * rstd * gc[e];
                st8(Y + (size_t)tok * DM + ch, y);
            }
            float cs[8], sn[8];
            {
                const float pf = (float)P.pos[tok];
#pragma unroll
                for (int e = 0; e < 8; ++e) {
                    constexpr float FRQ[8] = {1.0f, 0.1939227432012558f, 0.03760603070259094f, 0.007292664609849453f, 0.0014142135623842478f, 0.00027424818836152554f, 5.3182957344688475e-05f, 1.0313385246263351e-05f};
                    const float ang = pf * FRQ[e];
                    const double rev = (double)ang * 0.15915494309189535;
                    const float fx = (float)(rev - floor(rev));
                    cs[e] = __builtin_amdgcn_cosf(fx); sn[e] = __builtin_amdgcn_sinf(fx);
                }
            }
            {
                float qv[8], pv[8]; up8(cq, qv);
#pragma unroll
                for (int e = 0; e < 8; ++e) pv[e] = __shfl_xor(qv[e], 1);
#pragma unroll
                for (int e = 0; e < 8; ++e) {
                    float r = qv[e];
                    if (chunk == 0) r = qv[e] * cs[e] - pv[e] * sn[e];
                    else if (chunk == 1) r = qv[e] * cs[e] + pv[e] * sn[e];
                    qv[e] = r * QSCALE;
                }
                st8(Qr + (size_t)tok * 512 + ch, qv);
            }
#pragma unroll
            for (int p = 0; p < 2; ++p) {
                const int slot = p * 64 + lane, tensor = slot >> 4, g = (slot >> 3) & 1;
                const bool act = slot < 96;
                float kv[8], pv[8]; up8(p ? ck1 : ck0, kv);
#pragma unroll
                for (int e = 0; e < 8; ++e) pv[e] = __shfl_xor(kv[e], 1);
                if ((tensor & 1) == 0) {
#pragma unroll
                    for (int e = 0; e < 8; ++e) {
                        if (chunk == 0) kv[e] = kv[e] * cs[e] - pv[e] * sn[e];
                        else if (chunk == 1) kv[e] = kv[e] * cs[e] + pv[e] * sn[e];
                    }
                }
                if (act) {
                    bf16_t* base = (bf16_t*)(P.ws + WS_KV + (size_t)tensor * 4 * MiB) + (size_t)(b * 2 + g) * SEQ * 64;
                    if (tensor >= 2 && (tensor & 1) == 0) st8(base + ktile_off(s, chunk * 8), kv);
                }
            }
        }
    }
}

__device__ __forceinline__ void vtile_item(const Params& P, unsigned char* lds, int it, int lane, int wave) {
    const bf16_t* PROJ = (const bf16_t*)(P.ws + WS_BIG);
    bf16_t* tl = (bf16_t*)(lds + wave * 16384);
    const int r32 = lane & 31, hi = lane >> 5;
    {
        const int j = it & 127, bg = (it >> 7) & 3, tv = it >> 9;
        const int b = bg >> 1, g = bg & 1, tensor = 3 + 2 * tv;
        const bf16_t* src = PROJ + (size_t)(b * SEQ + j * 64 + lane) * PJ + C_KV + tensor * 128 + g * 64;
        WSYNC();
#pragma unroll
        for (int c = 0; c < 8; ++c) { const u32x4 v = *(const u32x4*)(src + c * 8);
            unsigned* d = (unsigned*)(tl + lane * 66 + c * 8); d[0] = v.x; d[1] = v.y; d[2] = v.z; d[3] = v.w; }
        WSYNC();
        bf16_t* dst = (bf16_t*)(P.ws + WS_KV + (size_t)tensor * 4 * MiB) + (size_t)bg * SEQ * 64 + (size_t)j * 4096;
#pragma unroll
        for (int f = 0; f < 8; ++f) {
            const int d = 32 * (f >> 2) + r32, kb = 16 * (f & 3) + 4 * hi;
            unsigned w[4];
#pragma unroll
            for (int q = 0; q < 4; ++q) { const int e0 = 2 * q, k0 = kb + (e0 & 3) + 8 * (e0 >> 2);
                w[q] = (unsigned)tl[k0 * 66 + d] | ((unsigned)tl[(k0 + 1) * 66 + d] << 16); }
            u32x4 o; o.x = w[0]; o.y = w[1]; o.z = w[2]; o.w = w[3];
            *(u32x4*)(dst + ((f * 64 + lane) << 3)) = o;
        }
    }
}
typedef short bf16x8 __attribute__((ext_vector_type(8)));
typedef float f32x16 __attribute__((ext_vector_type(16)));
typedef float f32x2_t __attribute__((ext_vector_type(2)));
typedef __bf16 bf16x2_t __attribute__((ext_vector_type(2)));
__device__ __forceinline__ unsigned cvtpk(float lo, float hi) { f32x2_t v = {lo, hi}; bf16x2_t b = __builtin_convertvector(v, bf16x2_t); return __builtin_bit_cast(unsigned, b); }
__device__ __forceinline__ float quad_sum(float v) {
    v += __builtin_bit_cast(float, __builtin_amdgcn_update_dpp(0, __builtin_bit_cast(int, v), 0xB1, 0xF, 0xF, true));
    v += __builtin_bit_cast(float, __builtin_amdgcn_update_dpp(0, __builtin_bit_cast(int, v), 0x4E, 0xF, 0xF, true));
    return v;
}
typedef const __attribute__((address_space(1))) char* gcptr;
__device__ __forceinline__ gcptr uni_ptr(const void* p) {
    const unsigned long long v = (unsigned long long)p;
    const unsigned lo = (unsigned)__builtin_amdgcn_readfirstlane((int)(unsigned)v), hi = (unsigned)__builtin_amdgcn_readfirstlane((int)(unsigned)(v >> 32));
    return (gcptr)(((unsigned long long)hi << 32) | lo);
}
__device__ __forceinline__ void ld_frags(bf16x8 (&f)[8], const bf16_t* tile, int lane) {
    gcptr b = uni_ptr(tile); const unsigned vo = (unsigned)lane * 16u;
#pragma unroll
    for (int i = 0; i < 8; ++i) f[i] = *(const __attribute__((address_space(1))) bf16x8*)(b + vo + i * 1024);
}
__device__ __forceinline__ void qk_tile(f32x16& s0, f32x16& s1, const bf16x8 (&kf)[8], const bf16x8 (&qf)[4]) {
    const f32x16 z = {0.f, 0.f, 0.f, 0.f, 0.f, 0.f, 0.f, 0.f, 0.f, 0.f, 0.f, 0.f, 0.f, 0.f, 0.f, 0.f};
    s0 = z; s1 = z;
    __builtin_amdgcn_s_setprio(1);
#pragma unroll
    for (int ds = 0; ds < 4; ++ds) {
        s0 = __builtin_amdgcn_mfma_f32_32x32x16_bf16(kf[ds], qf[ds], s0, 0, 0, 0);
        s1 = __builtin_amdgcn_mfma_f32_32x32x16_bf16(kf[4 + ds], qf[ds], s1, 0, 0, 0);
    }
    __builtin_amdgcn_s_setprio(0);
}
__device__ __forceinline__ void pv_tile(f32x16 (&o)[2], const f32x16& p0, const f32x16& p1, const bf16x8 (&vf)[8]) {
    u32x4 w0, w1, w2, w3;
    w0.x = cvtpk(p0[0], p0[1]); w0.y = cvtpk(p0[2], p0[3]); w0.z = cvtpk(p0[4], p0[5]); w0.w = cvtpk(p0[6], p0[7]);
    w1.x = cvtpk(p0[8], p0[9]); w1.y = cvtpk(p0[10], p0[11]); w1.z = cvtpk(p0[12], p0[13]); w1.w = cvtpk(p0[14], p0[15]);
    w2.x = cvtpk(p1[0], p1[1]); w2.y = cvtpk(p1[2], p1[3]); w2.z = cvtpk(p1[4], p1[5]); w2.w = cvtpk(p1[6], p1[7]);
    w3.x = cvtpk(p1[8], p1[9]); w3.y = cvtpk(p1[10], p1[11]); w3.z = cvtpk(p1[12], p1[13]); w3.w = cvtpk(p1[14], p1[15]);
    const bf16x8 b0 = __builtin_bit_cast(bf16x8, w0), b1 = __builtin_bit_cast(bf16x8, w1), b2 = __builtin_bit_cast(bf16x8, w2), b3 = __builtin_bit_cast(bf16x8, w3);
    __builtin_amdgcn_s_setprio(1);
#pragma unroll
    for (int d0 = 0; d0 < 2; ++d0) {
        o[d0] = __builtin_amdgcn_mfma_f32_32x32x16_bf16(vf[d0 * 4 + 0], b0, o[d0], 0, 0, 0);
        o[d0] = __builtin_amdgcn_mfma_f32_32x32x16_bf16(vf[d0 * 4 + 1], b1, o[d0], 0, 0, 0);
        o[d0] = __builtin_amdgcn_mfma_f32_32x32x16_bf16(vf[d0 * 4 + 2], b2, o[d0], 0, 0, 0);
        o[d0] = __builtin_amdgcn_mfma_f32_32x32x16_bf16(vf[d0 * 4 + 3], b3, o[d0], 0, 0, 0);
    }
    __builtin_amdgcn_s_setprio(0);
}
__device__ __forceinline__ float xhalf_max(float v) {
    const auto rr = __builtin_amdgcn_permlane32_swap(__float_as_uint(v), __float_as_uint(v), false, false);
    return fmaxf(__uint_as_float(rr[0]), __uint_as_float(rr[1]));
}
__device__ __forceinline__ float xhalf_sum(float v) {
    const auto rr = __builtin_amdgcn_permlane32_swap(__float_as_uint(v), __float_as_uint(v), false, false);
    return __uint_as_float(rr[0]) + __uint_as_float(rr[1]);
}
__device__ __forceinline__ void smax_step(f32x16& s0, f32x16& s1, float& m, float& l, f32x16 (&o)[2], bool sel) {
    float x0 = fmaxf(s0[0], s1[0]), x1 = fmaxf(s0[1], s1[1]), x2 = fmaxf(s0[2], s1[2]), x3 = fmaxf(s0[3], s1[3]);
#pragma unroll
    for (int r = 4; r < 16; r += 4) {
        x0 = fmaxf(x0, fmaxf(s0[r], s1[r])); x1 = fmaxf(x1, fmaxf(s0[r + 1], s1[r + 1])); x2 = fmaxf(x2, fmaxf(s0[r + 2], s1[r + 2])); x3 = fmaxf(x3, fmaxf(s0[r + 3], s1[r + 3]));
    }
    float mx = fmaxf(fmaxf(x0, x1), fmaxf(x2, x3));
    if (!sel) mx = NEGV;
    mx = xhalf_max(mx);
    const float mn = fmaxf(m, mx);
    if (__any(mn > m)) { const float al = __builtin_amdgcn_exp2f(m - mn); l *= al; o[0] *= al; o[1] *= al; }
    m = mn;
    const float me = sel ? mn : 1e30f;
    float a0 = 0.f, a1 = 0.f, a2 = 0.f, a3 = 0.f;
#pragma unroll
    for (int r = 0; r < 16; r += 2) {
        s0[r] = __builtin_amdgcn_exp2f(s0[r] - me); s0[r + 1] = __builtin_amdgcn_exp2f(s0[r + 1] - me);
        s1[r] = __builtin_amdgcn_exp2f(s1[r] - me); s1[r + 1] = __builtin_amdgcn_exp2f(s1[r + 1] - me);
        a0 += s0[r]; a1 += s0[r + 1]; a2 += s1[r]; a3 += s1[r + 1];
    }
    l += (a0 + a1) + (a2 + a3);
}
template <int KIND>
__device__ __forceinline__ void tile_body(f32x16 (&o)[2], float& m, float& l, bf16x8 (&kf)[8], const bf16x8 (&qf)[4], const bf16_t* vtile, const bf16_t* knext, int lane,
                                          int j, int s, int s0, int cur, bool sel, int hi) {
    bf16x8 vf[8]; ld_frags(vf, vtile, lane);
    asm volatile("" ::: "memory"); __builtin_amdgcn_sched_barrier(0);
    f32x16 a0, a1; qk_tile(a0, a1, kf, qf);
    asm volatile("" ::: "memory"); __builtin_amdgcn_sched_barrier(0);
    ld_frags(kf, knext, lane);
    asm volatile("" ::: "memory"); __builtin_amdgcn_sched_barrier(0);
    const int pb = 64 * j + 4 * hi;
    if (KIND == 0) {
        if (j == cur) {
#pragma unroll
            for (int r = 0; r < 16; ++r) { const int pos = pb + (r & 3) + 8 * (r >> 2); a0[r] = (sel && pos <= s) ? a0[r] : NEGV; a1[r] = (sel && pos + 32 <= s) ? a1[r] : NEGV; }
        }
    } else {
        if (64 * j + 63 > s0 || 64 * j < s0 + 7 - 511) {
#pragma unroll
            for (int r = 0; r < 16; ++r) { const int pos = pb + (r & 3) + 8 * (r >> 2);
                a0[r] = (pos <= s && pos >= s - 511) ? a0[r] : NEGV; a1[r] = (pos + 32 <= s && pos + 32 >= s - 511) ? a1[r] : NEGV; }
        }
    }
    smax_step(a0, a1, m, l, o, KIND == 0 ? sel : true);
    pv_tile(o, a0, a1, vf);
}
__device__ __forceinline__ int next_blk(unsigned& bits, int& w, unsigned U1, unsigned U2, unsigned U3) {
    while (bits == 0u && w < 3) { ++w; bits = (w == 1) ? U1 : (w == 2) ? U2 : U3; }
    if (bits == 0u) return -1;
    const int bp = __builtin_ctz(bits); bits &= bits - 1u; return 32 * w + bp;
}
__device__ __forceinline__ void attn_unit(const Params& P, float* impA, float* impB, int bg, int tg, int lane) {
    const int b = bg >> 1, g = bg & 1, s0 = tg * 8, r32 = lane & 31, hi = lane >> 5, tl = r32 >> 2, hh = r32 & 3;
    const int s = s0 + tl, tok = b * SEQ + s, cur = s0 >> 6;
    const bf16_t* PROJ = (const bf16_t*)(P.ws + WS_BIG);
    const bf16_t* Qr = (const bf16_t*)(P.ws + WS_Q);
    bf16_t* Y = (bf16_t*)(P.ws + WS_Y);
    const bf16_t* KCt = (const bf16_t*)(P.ws + WS_KCC) + (size_t)bg * 512 * 64;
    const bf16_t* VCt = (const bf16_t*)(P.ws + WS_VCC) + (size_t)bg * 512 * 64;
    const bf16_t* KSt = (const bf16_t*)(P.ws + WS_KV + 2 * 4 * MiB) + (size_t)bg * SEQ * 64;
    const bf16_t* VSt = (const bf16_t*)(P.ws + WS_KV + 3 * 4 * MiB) + (size_t)bg * SEQ * 64;
    const bf16_t* KWt = (const bf16_t*)(P.ws + WS_KV + 4 * 4 * MiB) + (size_t)bg * SEQ * 64;
    const bf16_t* VWt = (const bf16_t*)(P.ws + WS_KV + 5 * 4 * MiB) + (size_t)bg * SEQ * 64;
    bf16x8 qf[4];
    { const bf16_t* qp = Qr + (size_t)tok * 512 + (g * 4 + hh) * 64 + hi * 8;
#pragma unroll
      for (int ds = 0; ds < 4; ++ds) qf[ds] = *(const bf16x8*)(qp + ds * 16); }
    float g0, g1, g2;
    { const bf16_t* gp = PROJ + (size_t)tok * PJ + C_GT + g * 12 + hh * 3;
      g0 = 1.0f / (1.0f + __expf(-bf2f(gp[0]))); g1 = 1.0f / (1.0f + __expf(-bf2f(gp[1]))); g2 = 1.0f / (1.0f + __expf(-bf2f(gp[2]))); }
    const f32x16 z16 = {0.f, 0.f, 0.f, 0.f, 0.f, 0.f, 0.f, 0.f, 0.f, 0.f, 0.f, 0.f, 0.f, 0.f, 0.f, 0.f};
    f32x16 ocmp[2]; ocmp[0] = z16; ocmp[1] = z16;
    {
        const f32x4 z4 = {0.f, 0.f, 0.f, 0.f};
#pragma unroll
        for (int i = 0; i < 8; ++i) *(f32x4*)(impA + ((i * 64 + lane) << 2)) = z4;
    }
    WSYNC();
    const int sm = s0 + 7;
    int nvm = (sm >= 31) ? ((sm - 31) / 16 + 1) : 0; if (nvm > 511) nvm = 511;
    int nv = (s >= 31) ? ((s - 31) / 16 + 1) : 0; if (nv > 511) nv = 511;
    const int ntc = (nvm + 63) >> 6;
    int nvlo = (s0 >= 31) ? ((s0 - 31) / 16 + 1) : 0; if (nvlo > 511) nvlo = 511;
    if (ntc > 0) {
        float m = NEGV, l = 0.f;
        for (int c = 0; c < ntc; ++c) {
            bf16x8 kf[8]; ld_frags(kf, KCt + c * 4096, lane);
            f32x16 a0, a1; qk_tile(a0, a1, kf, qf);
            const int ib = 64 * c + 4 * hi;
            const bool full = 64 * (c + 1) <= nvlo;
            float mx = NEGV;
            if (!full) {
#pragma unroll
                for (int r = 0; r < 16; ++r) { const int i0 = ib + (r & 3) + 8 * (r >> 2); a0[r] = (i0 < nv) ? a0[r] : NEGV; a1[r] = (i0 + 32 < nv) ? a1[r] : NEGV; }
            }
#pragma unroll
            for (int r = 0; r < 16; ++r) mx = fmaxf(mx, fmaxf(a0[r], a1[r]));
            mx = xhalf_max(mx);
            const float mn = fmaxf(m, mx); l *= __builtin_amdgcn_exp2f(m - mn); m = mn;
            float sum = 0.f;
            if (full) {
#pragma unroll
                for (int r = 0; r < 16; ++r) sum += __builtin_amdgcn_exp2f(a0[r] - mn) + __builtin_amdgcn_exp2f(a1[r] - mn);
            } else {
#pragma unroll
                for (int r = 0; r < 16; ++r) { const int i0 = ib + (r & 3) + 8 * (r >> 2);
                    sum += ((i0 < nv) ? __builtin_amdgcn_exp2f(a0[r] - mn) : 0.f) + ((i0 + 32 < nv) ? __builtin_amdgcn_exp2f(a1[r] - mn) : 0.f); }
            }
            l += sum;
        }
        l = xhalf_sum(l);
        const float inv = (l > 0.f) ? 1.0f / l : 0.f;
        f32x16 o[2]; o[0] = z16; o[1] = z16;
        for (int c = 0; c < ntc; ++c) {
            bf16x8 kf[8], vf[8]; ld_frags(kf, KCt + c * 4096, lane); ld_frags(vf, VCt + c * 4096, lane);
            f32x16 a0, a1; qk_tile(a0, a1, kf, qf);
            const int ib = 64 * c + 4 * hi;
            if (64 * (c + 1) <= nvlo) {
#pragma unroll
                for (int r = 0; r < 16; ++r) { a0[r] = __builtin_amdgcn_exp2f(a0[r] - m) * inv; a1[r] = __builtin_amdgcn_exp2f(a1[r] - m) * inv; }
            } else {
#pragma unroll
                for (int r = 0; r < 16; ++r) { const int i0 = ib + (r & 3) + 8 * (r >> 2);
                    a0[r] = (i0 < nv) ? __builtin_amdgcn_exp2f(a0[r] - m) * inv : 0.f; a1[r] = (i0 + 32 < nv) ? __builtin_amdgcn_exp2f(a1[r] - m) * inv : 0.f; }
            }
#pragma unroll
            for (int rr = 0; rr < 4; ++rr) {
                float sa = (a0[4 * rr] + a0[4 * rr + 1]) + (a0[4 * rr + 2] + a0[4 * rr + 3]), sb = a0[4 * rr + 3];
                float ta = (a1[4 * rr] + a1[4 * rr + 1]) + (a1[4 * rr + 2] + a1[4 * rr + 3]), tb = a1[4 * rr + 3];
                sa = quad_sum(sa); sb = quad_sum(sb); ta = quad_sum(ta); tb = quad_sum(tb);
                const int j = 16 * c + 2 * rr + hi;
                if (hh == 0) { impA[tl * 128 + j] = sa; impB[tl * 128 + j + 1] = sb; impA[tl * 128 + j + 8] = ta; if (j + 9 < 128) impB[tl * 128 + j + 9] = tb; }
            }
            pv_tile(o, a0, a1, vf);
        }
        ocmp[0] = o[0] * g0; ocmp[1] = o[1] * g0;
    }
    WSYNC();
    unsigned U0 = 0u, U1 = 0u, U2 = 0u, U3 = 0u, mk0 = 0u, mk1 = 0u, mk2 = 0u, mk3 = 0u;
    {
        const unsigned long long lt = (lane == 0) ? 0ull : (~0ull >> (64 - lane));
        const int j0 = lane, j1 = lane + 64;
        const bool c0 = (j0 >= 1) && (j0 <= cur - 2), c1 = (j1 <= cur - 2);
        const bool f0 = (j0 == 0) || (j0 == cur) || (j0 == cur - 1), f1 = (j1 == cur) || (j1 == cur - 1);
        for (int t8 = 0; t8 < 8; ++t8) {
            bool sel0, sel1;
            if (cur - 2 <= 13) { sel0 = j0 <= cur; sel1 = j1 <= cur; }
            else {
                const float v0 = impA[t8 * 128 + j0] + impB[t8 * 128 + j0], v1 = impA[t8 * 128 + j1] + impB[t8 * 128 + j1];
                const unsigned k0 = c0 ? __float_as_uint(v0) : 0u, k1 = c1 ? __float_as_uint(v1) : 0u;
                unsigned Tt = 0u;
                for (int bit = 30; bit >= 0; --bit) {
                    const unsigned tr = Tt | (1u << bit);
                    const int cnt = __popcll(__ballot(k0 >= tr)) + __popcll(__ballot(k1 >= tr));
                    if (cnt >= 13) Tt = tr;
                    if (cnt == 13) break;
                }
                const bool gt0 = c0 && (k0 > Tt), gt1 = c1 && (k1 > Tt), eq0 = c0 && (k0 == Tt), eq1 = c1 && (k1 == Tt);
                const int rem = 13 - (__popcll(__ballot(gt0)) + __popcll(__ballot(gt1)));
                const unsigned long long e0 = __ballot(eq0), e1 = __ballot(eq1);
                const bool ch0 = gt0 || (eq0 && (__popcll(e0 & lt) < rem)), ch1 = gt1 || (eq1 && ((__popcll(e0) + __popcll(e1 & lt)) < rem));
                sel0 = f0 || ch0; sel1 = f1 || ch1;
            }
            const unsigned long long b0 = __ballot(sel0), b1 = __ballot(sel1);
            const unsigned w0 = (unsigned)b0, w1 = (unsigned)(b0 >> 32), w2 = (unsigned)b1, w3 = (unsigned)(b1 >> 32);
            U0 |= w0; U1 |= w1; U2 |= w2; U3 |= w3;
            if (tl == t8) { mk0 = w0; mk1 = w1; mk2 = w2; mk3 = w3; }
        }
    }
    WSYNC();
    float* stash = impA + lane;
#pragma unroll
    for (int r = 0; r < 16; ++r) { stash[r * 64] = ocmp[0][r]; stash[(16 + r) * 64] = ocmp[1][r]; }
    {
        float m = NEGV, l = 0.f; f32x16 o[2]; o[0] = z16; o[1] = z16;
        U0 = (unsigned)__builtin_amdgcn_readfirstlane((int)U0); U1 = (unsigned)__builtin_amdgcn_readfirstlane((int)U1);
        U2 = (unsigned)__builtin_amdgcn_readfirstlane((int)U2); U3 = (unsigned)__builtin_amdgcn_readfirstlane((int)U3);
        unsigned bits = U0; int w = 0;
        int j = next_blk(bits, w, U1, U2, U3);
        bf16x8 kf[8]; ld_frags(kf, KSt + (size_t)j * 4096, lane);
        while (j >= 0) {
            const int jn = next_blk(bits, w, U1, U2, U3);
            const unsigned mw = (j < 32) ? mk0 : (j < 64) ? mk1 : (j < 96) ? mk2 : mk3;
            const bool sel = ((mw >> (j & 31)) & 1u) != 0u;
            tile_body<0>(o, m, l, kf, qf, VSt + (size_t)j * 4096, KSt + (size_t)((jn >= 0) ? jn : j) * 4096, lane, j, s, s0, cur, sel, hi);
            j = jn;
        }
        l = xhalf_sum(l);
        const float sc = g1 / l;
#pragma unroll
        for (int r = 0; r < 16; ++r) { stash[r * 64] += o[0][r] * sc; stash[(16 + r) * 64] += o[1][r] * sc; }
    }
    f32x16 oacc[2];
    {
        float m = NEGV, l = 0.f; f32x16 o[2]; o[0] = z16; o[1] = z16;
        const int jhi = s0 >> 6; const int jlo = (s0 < 511) ? 0 : ((s0 - 511) >> 6);
        bf16x8 kf[8]; ld_frags(kf, KWt + (size_t)jhi * 4096, lane);
        for (int j = jhi; j >= jlo; --j)
            tile_body<1>(o, m, l, kf, qf, VWt + (size_t)j * 4096, KWt + (size_t)((j > jlo) ? j - 1 : j) * 4096, lane, j, s, s0, cur, true, hi);
        l = xhalf_sum(l);
        const float sc = g2 / l;
#pragma unroll
        for (int r = 0; r < 16; ++r) { oacc[0][r] = stash[r * 64] + o[0][r] * sc; oacc[1][r] = stash[(16 + r) * 64] + o[1][r] * sc; }
    }
    {
        float ss = 0.f;
#pragma unroll
        for (int r = 0; r < 16; ++r) ss += oacc[0][r] * oacc[0][r] + oacc[1][r] * oacc[1][r];
        ss = xhalf_sum(ss);
        const float rstd = 1.0f / sqrtf(ss * (1.0f / 64.0f) + EPS);
        const int cb = (g * 4 + hh) * 64;
#pragma unroll
        for (int d0 = 0; d0 < 2; ++d0)
#pragma unroll
            for (int rr = 0; rr < 4; ++rr) {
                const int d = 32 * d0 + 8 * rr + 4 * hi;
                const f32x4 gg = *(const f32x4*)(P.goa + cb + d);
                u32x2 w; w.x = pk2(oacc[d0][4 * rr] * rstd * gg.x, oacc[d0][4 * rr + 1] * rstd * gg.y); w.y = pk2(oacc[d0][4 * rr + 2] * rstd * gg.z, oacc[d0][4 * rr + 3] * rstd * gg.w);
                *(u32x2*)(Y + (size_t)tok * DM + 512 + cb + d) = w;
            }
    }
    WSYNC();
}
__device__ __forceinline__ void ph_attn(const Params& P, unsigned char* lds) {
    const int lane = threadIdx.x & 63, wave = __builtin_amdgcn_readfirstlane(threadIdx.x >> 6);
    const int gw = blockIdx.x * NWV + wave, NGW = gridDim.x * NWV;
    float* impA = (float*)(lds + wave * 8192); float* impB = impA + 1024;
    unsigned* qctr = (unsigned*)(P.ws + WS_BAR) + 4096;
    const int pref = (int)(xcc_id_hw() & 3u);
    for (int k = 0; k < 4; ++k) {
        const int bg = (pref + k) & 3;
        for (;;) {
            unsigned t = 0u;
            if (lane == 0) t = __hip_atomic_fetch_add(qctr + 64 * bg, 1u, __ATOMIC_RELAXED, __HIP_MEMORY_SCOPE_AGENT);
            t = (unsigned)__builtin_amdgcn_readfirstlane((int)t);
            if (t >= 1024u) break;
            attn_unit(P, impA, impB, bg, 1023 - (int)t, lane);
        }
    }
}

__device__ __forceinline__ void ph_compress(const Params& P, unsigned char* lds) {
    const int tid = threadIdx.x, lane = tid & 63, wave = __builtin_amdgcn_readfirstlane(tid >> 6), r32 = lane & 31, hi = lane >> 5;
    unsigned char* aspan = lds;
    bf16_t* hid = (bf16_t*)(lds + 67584);
    float* bias = (float*)(lds + 67584 + 32 * 264 * 2);
    const f32x16 z16 = {0.f, 0.f, 0.f, 0.f, 0.f, 0.f, 0.f, 0.f, 0.f, 0.f, 0.f, 0.f, 0.f, 0.f, 0.f, 0.f};
    for (int it = blockIdx.x; it < 128; it += gridDim.x) {
        const int X = it >> 6, bg = (it >> 4) & 3, ch = it & 15, i0 = ch * 32;
        const bf16_t* src = (const bf16_t*)(P.ws + WS_KV + (size_t)X * 4 * MiB) + (size_t)bg * SEQ * 64;
        const bf16_t* W1t = (const bf16_t*)(P.ws + (X ? WS_WC1V : WS_WC1K));
        const bf16_t* W2t = (const bf16_t*)(P.ws + (X ? WS_WC2V : WS_WC2K));
        const float* bpp = (const float*)(P.ws + WS_B1P) + X * 32 * 256;
        bf16_t* dst = (bf16_t*)(P.ws + (X ? WS_VCC : WS_KCC)) + (size_t)bg * 512 * 64;
        __syncthreads();
        {
            const bf16_t* PROJ = (const bf16_t*)(P.ws + WS_BIG);
            const int bb = bg >> 1, gg = bg & 1;
#pragma unroll 1
            for (int r = 0; r < 9; ++r) { const int e = tid + 512 * r;
                const int tk = e >> 3, c = e & 7, st = 16 * i0 + tk; const bool ok = (e < 528 * 8) && (st < SEQ);
                u32x4 v = {0u, 0u, 0u, 0u};
                if (ok) v = *(const u32x4*)(PROJ + (size_t)(bb * SEQ + st) * PJ + C_KV + X * 128 + gg * 64 + c * 8);
                u32x4 o; o.x = __shfl_xor(v.x, 1); o.y = __shfl_xor(v.y, 1); o.z = __shfl_xor(v.z, 1); o.w = __shfl_xor(v.w, 1);
                if (X == 0 && c < 2 && ok) {
                    float a[8], bq[8]; up8(v, a); up8(o, bq);
                    const float pf = (float)P.pos[bb * SEQ + st];
#pragma unroll
                    for (int q = 0; q < 8; ++q) {
                        constexpr float FRQ[8] = {1.0f, 0.1939227432012558f, 0.03760603070259094f, 0.007292664609849453f, 0.0014142135623842478f, 0.00027424818836152554f, 5.3182957344688475e-05f, 1.0313385246263351e-05f};
                        const float ang = pf * FRQ[q];
                        const double rev = (double)ang * 0.15915494309189535;
                        const float fx = (float)(rev - floor(rev));
                        const float cs = __builtin_amdgcn_cosf(fx), sn = __builtin_amdgcn_sinf(fx);
                        a[q] = (c == 0) ? (a[q] * cs - bq[q] * sn) : (a[q] * cs + bq[q] * sn);
                    }
                    v.x = pk2(a[0], a[1]); v.y = pk2(a[2], a[3]); v.z = pk2(a[4], a[5]); v.w = pk2(a[6], a[7]);
                }
                if (e < 528 * 8) *(u32x4*)(aspan + tk * 128 + ((c ^ ((tk >> 4) & 7)) << 4)) = v; }
        }
        if (tid < 256) { float v = 0.f;
#pragma unroll 8
            for (int ks = 0; ks < 32; ++ks) v += bpp[ks * 256 + tid];
            bias[tid] = v; }
        __syncthreads();
        f32x16 acc = z16;
        const bf16_t* bp1 = W1t + ((size_t)(wave * 128) * 64 + lane) * 8;
        bf16x8 wr[16];
#define CMP_LOAD16(dst, kb) do { } while (0)
#define CMP_MMA16(src, kb) do { } while (0)
#define CMP_FENCE() do { asm volatile("" ::: "memory"); __builtin_amdgcn_sched_barrier(0); } while (0)
#pragma unroll
        for (int q = 0; q < 16; ++q) wr[q] = *(const bf16x8*)(bp1 + (size_t)q * 512);
        CMP_FENCE();
#pragma unroll 1
        for (int kb = 0; kb < 8; ++kb) {
#pragma unroll
            for (int q = 0; q < 16; ++q) {
                const int ks = kb * 16 + q; const int tk = 16 * r32 + (ks >> 2), c = 2 * (ks & 3) + hi;
                const bf16x8 xa = *(const bf16x8*)(aspan + tk * 128 + ((c ^ ((tk >> 4) & 7)) << 4));
                acc = __builtin_amdgcn_mfma_f32_32x32x16_bf16(wr[q], xa, acc, 0, 0, 0);
                CMP_FENCE();
                wr[q] = *(const bf16x8*)(bp1 + (size_t)((kb < 7) ? ks + 16 : ks) * 512);
                CMP_FENCE();
            }
        }
#undef CMP_LOAD16
#undef CMP_MMA16
#undef CMP_FENCE
#pragma unroll
        for (int rr = 0; rr < 4; ++rr) {
            const int n0 = 32 * wave + 8 * rr + 4 * hi;
            const float v0 = silu_f(acc[4 * rr] + bias[n0]), v1 = silu_f(acc[4 * rr + 1] + bias[n0 + 1]), v2 = silu_f(acc[4 * rr + 2] + bias[n0 + 2]), v3 = silu_f(acc[4 * rr + 3] + bias[n0 + 3]);
            u32x2 w; w.x = cvtpk(v0, v1); w.y = cvtpk(v2, v3);
            *(u32x2*)(hid + r32 * 264 + n0) = w;
        }
        __syncthreads();
        if (wave < 2) {
            f32x16 c2 = z16;
#pragma unroll
            for (int ks = 0; ks < 16; ++ks) {
                const bf16x8 hf = *(const bf16x8*)(hid + r32 * 264 + ks * 16 + hi * 8);
                const bf16x8 wf = *(const bf16x8*)(W2t + (size_t)(32 * wave + r32) * 256 + ks * 16 + hi * 8);
                c2 = X ? __builtin_amdgcn_mfma_f32_32x32x16_bf16(hf, wf, c2, 0, 0, 0) : __builtin_amdgcn_mfma_f32_32x32x16_bf16(wf, hf, c2, 0, 0, 0);
            }
            if (!X) {
                const int kv = i0 + r32; const bool live = kv < 511;
#pragma unroll
                for (int rr = 0; rr < 4; ++rr) {
                    const int d0 = 32 * wave + 8 * rr + 4 * hi;
                    u32x2 w; w.x = cvtpk(c2[4 * rr], c2[4 * rr + 1]); w.y = cvtpk(c2[4 * rr + 2], c2[4 * rr + 3]);
                    if (!live) { w.x = 0u; w.y = 0u; }
                    *(u32x2*)(dst + ktile_off(kv, d0)) = w;
                }
            } else {
                if (i0 == 480 && hi == 1) c2[15] = 0.f;
                const int j = i0 >> 6;
#pragma unroll
                for (int ksl = 0; ksl < 2; ++ksl) {
                    u32x4 w; w.x = cvtpk(c2[8 * ksl], c2[8 * ksl + 1]); w.y = cvtpk(c2[8 * ksl + 2], c2[8 * ksl + 3]); w.z = cvtpk(c2[8 * ksl + 4], c2[8 * ksl + 5]); w.w = cvtpk(c2[8 * ksl + 6], c2[8 * ksl + 7]);
                    *(u32x4*)(dst + (size_t)j * 4096 + (((wave * 4 + 2 * (ch & 1) + ksl) * 64 + lane) << 3)) = w;
                }
            }
        }
        __syncthreads();
    }
}

#define GAS __attribute__((address_space(1)))
#define LAS __attribute__((address_space(3)))
#define XB_TMO      128
#define XB_XCNT(j)  (256  + 64 * (j))
#define XB_XSUB(j)  (1280 + 64 * (j))
#define XB_XGEN(j)  (2304 + 64 * (j))
#define XB_TOP      3328
#define XB_TOPGEN   3392
#define XCD_BAR_WORDS 3456
#define XB_SPIN_CAP (1u << 18)

__device__ __forceinline__ unsigned xb_ld(unsigned* p)              { return __hip_atomic_load(p, __ATOMIC_RELAXED, __HIP_MEMORY_SCOPE_AGENT); }
__device__ __forceinline__ unsigned xb_add(unsigned* p, unsigned v) { return __hip_atomic_fetch_add(p, v, __ATOMIC_RELAXED, __HIP_MEMORY_SCOPE_AGENT); }
__device__ __forceinline__ unsigned xb_xcc_id() { return (unsigned)__builtin_amdgcn_s_getreg((3 << 11) | 20) & 0xFu; }
#define XB_SPIN(cond, bar) do { unsigned _sp = 0; while (cond) { __builtin_amdgcn_s_sleep(1); \
    if ((++_sp & 255u) == 0u) { if (xb_ld(&(bar)[XB_TMO])) break; if (_sp > XB_SPIN_CAP) { atomicAdd(&(bar)[XB_TMO], 1u); break; } } } } while (0)

struct XcdBarrier {
    unsigned* bar; unsigned x;
    volatile LAS unsigned* st;
};

__device__ __forceinline__ XcdBarrier xcd_barrier_post(unsigned* bar, volatile LAS unsigned* st) {
    XcdBarrier b; b.bar = bar; b.x = xb_xcc_id(); b.st = st;
    if (threadIdx.x == 0) (void)xb_add(&bar[XB_XCNT(b.x)], 1u);
    return b;
}
__device__ __forceinline__ void xcd_barrier_complete(unsigned* bar, unsigned x, unsigned& nloc, unsigned& nx) {
    const unsigned G = gridDim.x * gridDim.y * gridDim.z;
    unsigned sum, cnt, mine, sp = 0u;
    for (;;) {
        sum = 0u; cnt = 0u; mine = 0u;
#pragma unroll
        for (unsigned j = 0; j < 16; ++j) { const unsigned c = xb_ld(&bar[XB_XCNT(j)]); sum += c; cnt += (c > 0u) ? 1u : 0u; mine = (j == x) ? c : mine; }
        if (sum == G) break;
        __builtin_amdgcn_s_sleep(1);
        if ((++sp & 255u) == 0u) { if (xb_ld(&bar[XB_TMO])) break; if (sp > XB_SPIN_CAP) { atomicAdd(&bar[XB_TMO], 1u); break; } }
    }
    nloc = mine > 0u ? mine : 1u; nx = cnt > 0u ? cnt : 1u;
}

__device__ __forceinline__ void xcd_barrier(const XcdBarrier& b) {
    asm volatile("s_waitcnt vmcnt(0)" ::: "memory");
    __syncthreads();
    if (threadIdx.x == 0) {
        unsigned* bar = b.bar;
        __builtin_amdgcn_s_waitcnt(0);
        unsigned nloc = b.st[0], nx = b.st[1];
        if (nloc == 0u) { xcd_barrier_complete(bar, b.x, nloc, nx); b.st[0] = nloc; b.st[1] = nx; }
        const unsigned old = xb_add(&bar[XB_XSUB(b.x)], 1u);
        const unsigned gen = old / nloc;
        if (old + 1u == (gen + 1u) * nloc) {
            __builtin_amdgcn_fence(__ATOMIC_RELEASE, "agent");
            asm volatile("s_waitcnt vmcnt(0)" ::: "memory");
            const unsigned og = xb_add(&bar[XB_TOP], 1u);
            const unsigned tg = og / nx;
            if (og + 1u == (tg + 1u) * nx) xb_add(&bar[XB_TOPGEN], 1u);
            else XB_SPIN(xb_ld(&bar[XB_TOPGEN]) == tg, bar);
            __builtin_amdgcn_fence(__ATOMIC_ACQUIRE, "agent");
            xb_add(&bar[XB_XGEN(b.x)], 1u);
            asm volatile("s_waitcnt vmcnt(0)" ::: "memory");
        } else {
            XB_SPIN(xb_ld(&bar[XB_XGEN(b.x)]) == gen, bar);
            __builtin_amdgcn_fence(__ATOMIC_ACQUIRE, "agent");
            asm volatile("s_waitcnt vmcnt(0)" ::: "memory");
        }
    }
    __syncthreads();
}

__global__ void __launch_bounds__(NTHR) mega(Params P, int lo, int hi) {
    extern __shared__ __attribute__((aligned(16))) unsigned char lds[];
    cg::grid_group grid = cg::this_grid();
#ifndef REPMASK
#define REPMASK 0
#endif
#ifndef PHMASK
#define PHMASK 0xFFFF
#endif
#define IN(k) ((((PHMASK) >> (k)) & 1) && lo <= (k) && (k) < hi)
#define REP(k) (((REPMASK) >> (k)) & 1)
    unsigned* barw = (unsigned*)(P.ws + WS_BAR);
    volatile LAS unsigned* MISC = (volatile LAS unsigned*)((LAS unsigned char*)lds + 131072 + 8192 + 256);
    if (threadIdx.x < 16) MISC[threadIdx.x] = 0u;
    __syncthreads();
    if (hi == -12345) grid.sync();
    XcdBarrier xbar = xcd_barrier_post(barw, MISC);
#define SEAM(k) xcd_barrier(xbar)
    bf16_t* XN = (bf16_t*)(P.ws + WS_XN); bf16_t* BIG = (bf16_t*)(P.ws + WS_BIG); bf16_t* Y = (bf16_t*)(P.ws + WS_Y);
    const float* MOD = (const float*)(P.ws + WS_MOD);
    __attribute__((address_space(3))) unsigned char* glds = (__attribute__((address_space(3))) unsigned char*)lds;
#ifdef XSYNC
#pragma nounroll
    for (int xs = 0; xs < XSYNC; ++xs) grid.sync();
#endif
    if (IN(0)) {
#pragma nounroll
        for (int rep = 0; rep < 1 + REP(0); ++rep) { if (rep) xcd_barrier(xbar); ph_mod_partial(P, lds); ph_weights(P, lds); }
    }
    SEAM(0);
    if (IN(1)) {
#pragma nounroll
        for (int rep = 0; rep < 1 + REP(1); ++rep) { if (rep) xcd_barrier(xbar); ph_norm(P, lds, P.x, P.g_ffn1, 0, true); }
    }
    SEAM(1);
    if (IN(2)) {
#pragma nounroll
        for (int rep = 0; rep < 1 + REP(2); ++rep) { if (rep) xcd_barrier(xbar);
        pg8::Gemm g{XN, (const bf16_t*)(P.ws + WS_W1GU), T, 2 * DFF, DM}; pg8::StaticOrder S; S.init(T, 2 * DFF, (int)gridDim.x, (int)blockIdx.x);
        pg8::EpiSwiglu E{BIG, DFF}; pg8::gemm_phase<pg8::EpiSwiglu, pg8::StaticOrder, true, true>(glds, g, S, E); }
    }
    SEAM(2);
    if (IN(3)) { pg8::Gemm g{BIG, (const bf16_t*)(P.ws + WS_W1D), T, DM, DFF}; pg8::StaticOrder S; S.init(T, DM, (int)gridDim.x, (int)blockIdx.x);
        pg8::EpiResidN E{P.x, P.out, MOD + 2 * DM, 0.5f, XN, P.g_mix, MOD + 4 * DM, (float*)(P.ws + WS_RSS)};
        pg8::gemm_phase<pg8::EpiResidN, pg8::StaticOrder, true, true>(glds, g, S, E);
        ph_bias_gemv(P, (const bf16_t*)(P.ws + WS_WIN), PJ, 3); }
    SEAM(3);
    if (IN(5)) { pg8::Gemm g{XN, (const bf16_t*)(P.ws + WS_WIN), T, PJ, DM}; pg8::StaticOrder S; S.init(T, PJ, (int)gridDim.x, (int)blockIdx.x);
        pg8::EpiBf16N E{BIG, PJ, (const float*)(P.ws + WS_RSS), (const float*)(P.ws + WS_BIAS), PJ}; pg8::gemm_phase<pg8::EpiBf16N, pg8::StaticOrder, true, true>(glds, g, S, E); }
    SEAM(5);
    if (IN(6)) { ph_compress(P, lds); ph_post(P, lds); }
    SEAM(6);
    if (IN(8)) {
#pragma nounroll
        for (int rep = 0; rep < 1 + REP(8); ++rep) { if (rep) xcd_barrier(xbar); ph_attn(P, lds); }
    }
    SEAM(8);
    if (IN(9)) { pg8::Gemm g{Y, (const bf16_t*)(P.ws + WS_WOUT), T, DM, DM}; pg8::StaticOrder S; S.init(T, DM, (int)gridDim.x, (int)blockIdx.x);
        pg8::EpiResidN E{P.out, P.out, MOD + 5 * DM, 1.0f, XN, P.g_ffn2, MOD + 7 * DM, (float*)(P.ws + WS_RSS)};
        pg8::gemm_phase<pg8::EpiResidN, pg8::StaticOrder, true, true>(glds, g, S, E);
        ph_bias_gemv(P, (const bf16_t*)(P.ws + WS_W2GU), 2 * DFF, 6); }
    SEAM(9);
    if (IN(11)) { pg8::Gemm g{XN, (const bf16_t*)(P.ws + WS_W2GU), T, 2 * DFF, DM}; pg8::StaticOrder S; S.init(T, 2 * DFF, (int)gridDim.x, (int)blockIdx.x);
        pg8::EpiSwigluN E{BIG, DFF, (const float*)(P.ws + WS_RSS), (const float*)(P.ws + WS_BIAS), 2 * DFF}; pg8::gemm_phase<pg8::EpiSwigluN, pg8::StaticOrder, true, true>(glds, g, S, E); }
    SEAM(11);
    if (IN(12)) { pg8::Gemm g{BIG, (const bf16_t*)(P.ws + WS_W2D), T, DM, DFF}; pg8::StaticOrder S; S.init(T, DM, (int)gridDim.x, (int)blockIdx.x);
        pg8::EpiResid E{P.out, P.out, MOD + 8 * DM, 0.5f}; pg8::gemm_phase<pg8::EpiResid, pg8::StaticOrder, true, true>(glds, g, S, E); }
    SEAM(12);
    if (IN(13)) ph_final_norm(P);
}
constexpr int NPHASE = 14;

extern "C" void kernel_launch(void* const* d_in, const int* in_sizes, int n_in, void* d_out, int out_size, void* d_ws, size_t ws_size, hipStream_t stream) {
    static int grid = 0;
    if (grid == 0) {
        int dev = 0, cus = 0, per_cu = 0;
        hipGetDevice(&dev);
        hipDeviceGetAttribute(&cus, hipDeviceAttributeMultiprocessorCount, dev);
        hipFuncSetAttribute((const void*)mega, hipFuncAttributeMaxDynamicSharedMemorySize, LDS_BYTES);
        hipOccupancyMaxActiveBlocksPerMultiprocessor(&per_cu, (const void*)mega, NTHR, LDS_BYTES);
        if (per_cu < 1) { fprintf(stderr, "kernel_launch: occupancy query reports %d blocks per CU\n", per_cu); per_cu = 1; }
        grid = cus * per_cu;
        (void)hipGetLastError();
    }
    (void)hipMemsetAsync((unsigned char*)d_ws + WS_BAR, 0, 4096 * 4 + 2048, stream);
    Params p{};
    const void** pp = (const void**)&p;
    for (int i = 0; i < 26; ++i) pp[i] = d_in[i];
    p.out = (float*)d_out; p.ws = (unsigned char*)d_ws;
    int lo = 0, hi = NPHASE;
    void* args[] = {&p, &lo, &hi};
    hipError_t e = hipLaunchCooperativeKernel((const void*)mega, dim3(grid), dim3(NTHR), args, LDS_BYTES, stream);
    if (e != hipSuccess) fprintf(stderr, "cooperative launch failed: %s (grid %d)\n", hipGetErrorString(e), grid);
}
```

```cpp
#include <hip/hip_runtime.h>
#include <hip/hip_cooperative_groups.h>
#include <cstdio>
#include <cstdint>
namespace cg = cooperative_groups;

typedef unsigned short bf16_t;
typedef float f32x4 __attribute__((ext_vector_type(4)));
typedef unsigned u32x4 __attribute__((ext_vector_type(4)));
typedef unsigned u32x2 __attribute__((ext_vector_type(2)));

constexpr int NB = 2, SEQ = 8192, DM = 1024, T = NB * SEQ, DFF = 2816, INW = 2840, PJ = 3072;
constexpr int NMODC = 9 * DM;
constexpr float EPS = 1e-6f;
constexpr float QSCALE = 0.125f * 1.4426950408889634f;
constexpr int NTHR = 512, NWV = 8;
constexpr int LDS_BYTES = 147456;
constexpr float NEGV = -1e30f, BIGV = 1e9f;
constexpr int C_CB = 0, C_CC = 512, C_CX = 1024, C_Q = 1536, C_KV = 2048, C_GT = 2816;

constexpr size_t MiB = 1u << 20;
constexpr size_t WS_MODP = 0, WS_MOD = 2 * MiB, WS_B1P = 3 * MiB  , WS_BAR = 3 * MiB + 262144  , WS_XN = 4 * MiB, WS_Y = 36 * MiB, WS_BIG = 68 * MiB, WS_Q = 164 * MiB,
                 WS_KV = 180 * MiB  , WS_KCC = 204 * MiB, WS_VCC = 205 * MiB,
                 WS_W1GU = 206 * MiB, WS_W1D = 217 * MiB, WS_W2GU = 223 * MiB, WS_W2D = 234 * MiB, WS_WIN = 240 * MiB, WS_WOUT = 246 * MiB,
                 WS_WC1K = 248 * MiB, WS_WC1V = 249 * MiB, WS_WC2K = 250 * MiB, WS_WC2V = 250 * MiB + 65536, WS_RSS = 251 * MiB  , WS_BIAS = 252 * MiB  , WS_END = 253 * MiB;

struct Params {
    const float* x; const float* c; const int* pos; const float* w_ada; const float* b_ada; const float* g_ffn1;
    const float* w1g; const float* w1u; const float* w1d; const float* g_mix; const float* w_in; const float* conv_w;
    const float* cpk; const float* cpv; const float* wck1; const float* wck2; const float* wcv1; const float* wcv2;
    const float* goc; const float* goa; const float* w_out; const float* g_ffn2; const float* w2g; const float* w2u;
    const float* w2d; const float* g_final;
    float* out; unsigned char* ws;
};

__device__ __forceinline__ unsigned f2bf(float f) { unsigned u = __float_as_uint(f); return (u + 0x7fffu + ((u >> 16) & 1u)) >> 16; }
__device__ __forceinline__ float bf2f(unsigned v) { return __uint_as_float(v << 16); }
__device__ __forceinline__ unsigned pk2(float lo, float hi) { return f2bf(lo) | (f2bf(hi) << 16); }
__device__ __forceinline__ void ld8(const bf16_t* p, float (&v)[8]) {
    const u32x4 w = *(const u32x4*)p;
    v[0] = bf2f(w.x & 0xffffu); v[1] = bf2f(w.x >> 16); v[2] = bf2f(w.y & 0xffffu); v[3] = bf2f(w.y >> 16);
    v[4] = bf2f(w.z & 0xffffu); v[5] = bf2f(w.z >> 16); v[6] = bf2f(w.w & 0xffffu); v[7] = bf2f(w.w >> 16);
}
__device__ __forceinline__ void st8(bf16_t* p, const float (&v)[8]) {
    u32x4 w; w.x = pk2(v[0], v[1]); w.y = pk2(v[2], v[3]); w.z = pk2(v[4], v[5]); w.w = pk2(v[6], v[7]);
    *(u32x4*)p = w;
}
__device__ __forceinline__ float wave_sum(float v) {
#pragma unroll
    for (int o = 1; o < 64; o <<= 1) v += __shfl_xor(v, o);
    return v;
}
__device__ __forceinline__ float wave_max(float v) {
#pragma unroll
    for (int o = 1; o < 64; o <<= 1) v = fmaxf(v, __shfl_xor(v, o));
    return v;
}
__device__ __forceinline__ float silu_f(float v) { return v / (1.0f + expf(-v)); }
__device__ __forceinline__ unsigned xcc_id_hw() { return (unsigned)__builtin_amdgcn_s_getreg((3 << 11) | 20) & 0xFu; }
#define WSYNC() do { asm volatile("s_waitcnt lgkmcnt(0)" ::: "memory"); __builtin_amdgcn_wave_barrier(); } while (0)

namespace pg8 {
#define PG8_LAS __attribute__((address_space(3)))
typedef unsigned short bf16_t;
typedef short bf16x8 __attribute__((ext_vector_type(8)));
typedef float f32x4 __attribute__((ext_vector_type(4)));
typedef unsigned u32x4 __attribute__((ext_vector_type(4)));
constexpr int BM = 256, BK = 64, HALF = 128, HTB = HALF * BK * 2  , STAGE_BYTES = 8 * HTB, NXCD = 8, WGM = 8;

__host__ __device__ __forceinline__ int lds_byte(int r, int c) { const int st = (r >> 4) * 2 + (c >> 5), rr = r & 15, cc = c & 31, ob = rr * 64 + cc * 2; return st * 1024 + (ob ^ (((ob >> 9) & 1) << 5)); }
__host__ __device__ __forceinline__ void stage_rc(int b, int& R, int& C) { const int st = b / 1024, sb = b % 1024, swz = sb ^ (((sb >> 9) & 1) << 5); R = (st >> 1) * 16 + swz / 64; C = (st & 1) * 32 + (swz % 64) / 2; }
__host__ __device__ __forceinline__ int perm32(int rho) { const int n = rho >> 4, i = rho & 15; return 8 * (i >> 2) + 4 * n + (i & 3); }

struct Unit { int pm, pn; };
struct Gemm { const bf16_t* A; const bf16_t* Bt; int M, N, K; };

struct StaticOrder {
    int nM, nN, nwg, G, c;
    __host__ __device__ void init(int M, int N, int G_, int c_) { nM = M / BM; nN = N / BM; nwg = nM * nN; G = G_; c = c_; }
    __host__ __device__ bool next(int i, Unit& u) const {
        const long L = (long)i * G + c; if (L >= nwg) return false;
        int wgid = (int)L; { const int q = nwg / NXCD, r = nwg % NXCD, xcd = wgid % NXCD, off = wgid / NXCD; wgid = (xcd < r ? xcd * (q + 1) : r * (q + 1) + (xcd - r) * q) + off; }
        const int nig = WGM * nN, gid = wgid / nig, fm = gid * WGM, gsz = (nM - fm) < WGM ? (nM - fm) : WGM;
        u.pm = fm + ((wgid % nig) % gsz); u.pn = (wgid % nig) / gsz; return true;
    }
    __device__ __forceinline__ void a_ready(const Unit&) const {}
    __device__ __forceinline__ void done(const Unit&) const {}
};

__device__ __forceinline__ unsigned cvt_pk_bf16(float lo, float hi) { unsigned r; asm volatile("v_cvt_pk_bf16_f32 %0, %1, %2" : "=v"(r) : "v"(lo), "v"(hi)); return r; }
typedef float f32x2 __attribute__((ext_vector_type(2)));

__device__ __forceinline__ float silu_fast(float v) { return v * __builtin_amdgcn_rcpf(1.0f + __expf(-v)); }
struct EpiBf16 {
    static constexpr bool PERM = true, AFTER_DRAIN = false;
    bf16_t* O; int ldc;
    __device__ __forceinline__ void operator()(const f32x4 (&acc)[2][2][4][2], const Unit& u, int wr, int wc, int fr, int fq) const {
        const int row0 = u.pm * BM + wr * 64 + fr, col0 = u.pn * BM + wc * 32 + 8 * fq;
#pragma unroll
        for (int ai = 0; ai < 2; ++ai)
#pragma unroll
            for (int m = 0; m < 4; ++m) { bf16_t* rowp = O + (size_t)(row0 + ai * HALF + m * 16) * ldc + col0;
#pragma unroll
                for (int bj = 0; bj < 2; ++bj) { const f32x4 v0 = acc[ai][bj][m][0], v1 = acc[ai][bj][m][1];
                    u32x4 w; w.x = cvt_pk_bf16(v0[0], v0[1]); w.y = cvt_pk_bf16(v0[2], v0[3]); w.z = cvt_pk_bf16(v1[0], v1[1]); w.w = cvt_pk_bf16(v1[2], v1[3]);
                    *(u32x4*)(rowp + bj * HALF) = w; } }
    }
};
struct EpiSwiglu {
    static constexpr bool PERM = true, AFTER_DRAIN = false;
    bf16_t* O; int ldc;
    __device__ __forceinline__ void operator()(const f32x4 (&acc)[2][2][4][2], const Unit& u, int wr, int wc, int fr, int fq) const {
        const int row0 = u.pm * BM + wr * 64 + fr, col0 = u.pn * HALF + wc * 32 + 8 * fq;
#pragma unroll
        for (int ai = 0; ai < 2; ++ai)
#pragma unroll
            for (int m = 0; m < 4; ++m) { bf16_t* rowp = O + (size_t)(row0 + ai * HALF + m * 16) * ldc + col0;
                const f32x4 g0 = acc[ai][0][m][0], g1 = acc[ai][0][m][1], u0 = acc[ai][1][m][0], u1 = acc[ai][1][m][1];
                u32x4 w;
                w.x = cvt_pk_bf16(silu_fast(g0[0]) * u0[0], silu_fast(g0[1]) * u0[1]); w.y = cvt_pk_bf16(silu_fast(g0[2]) * u0[2], silu_fast(g0[3]) * u0[3]);
                w.z = cvt_pk_bf16(silu_fast(g1[0]) * u1[0], silu_fast(g1[1]) * u1[1]); w.w = cvt_pk_bf16(silu_fast(g1[2]) * u1[2], silu_fast(g1[3]) * u1[3]);
                *(u32x4*)rowp = w; }
    }
};
struct EpiResid {
    static constexpr bool PERM = false, AFTER_DRAIN = false;
    const float* base; float* out; const float* gate; float gs;
    __device__ __forceinline__ void operator()(const f32x4 (&acc)[2][2][4][2], const Unit& u, int wr, int wc, int fr, int fq) const {
        const int row0 = u.pm * BM + wr * 64 + fr, col0 = u.pn * BM + wc * 32 + 4 * fq;
        const float* gp = gate + (size_t)(u.pm / 32) * 9216;
#pragma unroll
        for (int bj = 0; bj < 2; ++bj)
#pragma unroll
            for (int n = 0; n < 2; ++n) { const int c = col0 + bj * HALF + n * 16; const f32x4 gt = *(const f32x4*)(gp + c) * gs;
#pragma unroll
                for (int ai = 0; ai < 2; ++ai)
#pragma unroll
                    for (int m = 0; m < 4; ++m) { const size_t off = (size_t)(row0 + ai * HALF + m * 16) * 1024 + c;
                        *(f32x4*)(out + off) = *(const f32x4*)(base + off) + gt * acc[ai][bj][m][n]; } }
    }
};

struct EpiResidN {
    static constexpr bool PERM = false, AFTER_DRAIN = false;
    const float* base; float* out; const float* gate; float gs; bf16_t* xn; const float* gnorm; const float* scale; float* rss;
    __device__ __forceinline__ void operator()(const f32x4 (&acc)[2][2][4][2], const Unit& u, int wr, int wc, int fr, int fq) const {
        const int row0 = u.pm * BM + wr * 64 + fr, col0 = u.pn * BM + wc * 32 + 4 * fq;
        const float* gp = gate + (size_t)(u.pm / 32) * 9216 + col0; const float* sp = scale + (size_t)(u.pm / 32) * 9216 + col0; const float* np = gnorm + col0;
#pragma unroll
        for (int ai = 0; ai < 2; ++ai)
#pragma unroll
            for (int m = 0; m < 4; ++m) {
                const int row = row0 + ai * HALF + m * 16; float ss = 0.f;
#pragma unroll
                for (int bj = 0; bj < 2; ++bj)
#pragma unroll
                    for (int n = 0; n < 2; ++n) { const int cl = bj * HALF + n * 16;
                        const f32x4 gt = *(const f32x4*)(gp + cl) * gs, gsv = *(const f32x4*)(np + cl) * (*(const f32x4*)(sp + cl) + 1.0f);
                        const unsigned off = (unsigned)(row * 1024 + col0 + cl);
                        const f32x4 o = *(const f32x4*)(base + off) + gt * acc[ai][bj][m][n];
                        *(f32x4*)(out + off) = o;
                        ss += (o[0] * o[0] + o[1] * o[1]) + (o[2] * o[2] + o[3] * o[3]);
                        const f32x4 h = o * gsv;
                        u32x2 w; w.x = cvt_pk_bf16(h[0], h[1]); w.y = cvt_pk_bf16(h[2], h[3]);
                        *(u32x2*)(xn + off) = w; }
                ss += __shfl_xor(ss, 16); ss += __shfl_xor(ss, 32);
                if (fq == 0) rss[(unsigned)(row * 16 + u.pn * 4 + wc)] = ss;
                if (m & 1) asm volatile("" ::: "memory");
            }
    }
};
__device__ __forceinline__ float row_rstd(const float* rss, int row) {
    const f32x4* p = (const f32x4*)(rss + (size_t)row * 16);
    const f32x4 a = p[0], b = p[1], c = p[2], d = p[3];
    const float s = ((a[0] + a[1]) + (a[2] + a[3])) + ((b[0] + b[1]) + (b[2] + b[3])) + ((c[0] + c[1]) + (c[2] + c[3])) + ((d[0] + d[1]) + (d[2] + d[3]));
    return 1.0f / sqrtf(s * (1.0f / 1024.0f) + 1e-6f);
}
struct EpiBf16N {
    static constexpr bool PERM = true, AFTER_DRAIN = false;
    bf16_t* O; int ldc; const float* rss; const float* bias; int nbias;
    __device__ __forceinline__ void operator()(const f32x4 (&acc)[2][2][4][2], const Unit& u, int wr, int wc, int fr, int fq) const {
        const int row0 = u.pm * BM + wr * 64 + fr, col0 = u.pn * BM + wc * 32 + 8 * fq;
        const float* bp = bias + (size_t)(u.pm / 32) * nbias + col0;
        f32x4 bv[2][2];
#pragma unroll
        for (int bj = 0; bj < 2; ++bj)
#pragma unroll
            for (int n = 0; n < 2; ++n) bv[bj][n] = *(const f32x4*)(bp + bj * HALF + 4 * n);
#pragma unroll
        for (int ai = 0; ai < 2; ++ai)
#pragma unroll
            for (int m = 0; m < 4; ++m) { const int row = row0 + ai * HALF + m * 16; const float rs = row_rstd(rss, row); bf16_t* rowp = O + (size_t)row * ldc + col0;
#pragma unroll
                for (int bj = 0; bj < 2; ++bj) { const f32x4 v0 = acc[ai][bj][m][0] * rs + bv[bj][0], v1 = acc[ai][bj][m][1] * rs + bv[bj][1];
                    u32x4 w; w.x = cvt_pk_bf16(v0[0], v0[1]); w.y = cvt_pk_bf16(v0[2], v0[3]); w.z = cvt_pk_bf16(v1[0], v1[1]); w.w = cvt_pk_bf16(v1[2], v1[3]);
                    *(u32x4*)(rowp + bj * HALF) = w; } }
    }
};
struct EpiSwigluN {
    static constexpr bool PERM = true, AFTER_DRAIN = false;
    bf16_t* O; int ldc; const float* rss; const float* bias; int nbias;
    __device__ __forceinline__ void operator()(const f32x4 (&acc)[2][2][4][2], const Unit& u, int wr, int wc, int fr, int fq) const {
        const int row0 = u.pm * BM + wr * 64 + fr, col0 = u.pn * HALF + wc * 32 + 8 * fq;
        const float* bp = bias + (size_t)(u.pm / 32) * nbias + u.pn * BM + wc * 32 + 8 * fq;
        const f32x4 bg0 = *(const f32x4*)(bp), bg1 = *(const f32x4*)(bp + 4), bu0 = *(const f32x4*)(bp + HALF), bu1 = *(const f32x4*)(bp + HALF + 4);
#pragma unroll
        for (int ai = 0; ai < 2; ++ai)
#pragma unroll
            for (int m = 0; m < 4; ++m) { const int row = row0 + ai * HALF + m * 16; const float rs = row_rstd(rss, row); bf16_t* rowp = O + (size_t)row * ldc + col0;
                const f32x4 g0 = acc[ai][0][m][0] * rs + bg0, g1 = acc[ai][0][m][1] * rs + bg1, u0 = acc[ai][1][m][0] * rs + bu0, u1 = acc[ai][1][m][1] * rs + bu1;
                u32x4 w;
                w.x = cvt_pk_bf16(silu_fast(g0[0]) * u0[0], silu_fast(g0[1]) * u0[1]); w.y = cvt_pk_bf16(silu_fast(g0[2]) * u0[2], silu_fast(g0[3]) * u0[3]);
                w.z = cvt_pk_bf16(silu_fast(g1[0]) * u1[0], silu_fast(g1[1]) * u1[1]); w.w = cvt_pk_bf16(silu_fast(g1[2]) * u1[2], silu_fast(g1[3]) * u1[3]);
                *(u32x4*)rowp = w; }
    }
};
template <class Epi, class Sched, bool ALIGN_EPI = false, bool SP2 = false>
__device__ __forceinline__ void gemm_phase(PG8_LAS unsigned char* lds, const Gemm g, const Sched& S, const Epi& E) {
    const int tid = threadIdx.x, wid = __builtin_amdgcn_readfirstlane(tid >> 6), lane = tid & 63, wr = wid >> 2, wc = wid & 3, fr = lane & 15, fq = lane >> 4;
    const int K = g.K, nt = K / BK;
    unsigned voffA[2], voffB[2];
#pragma unroll
    for (int i = 0; i < 2; ++i) { int R, C; stage_rc(tid * 16 + i * 8192, R, C); const int Rb = Epi::PERM ? ((R & ~31) + perm32(R & 31)) : R;
        voffA[i] = (unsigned)(R * K + C) * 2u; voffB[i] = (unsigned)(Rb * K + C) * 2u; }
    const size_t kstep = (size_t)(BK * 2);
    const size_t hstep = (size_t)HALF * K * 2;
    const size_t tstep = 2 * hstep;
    const unsigned ldsw = (unsigned)wid * 1024u;
    const int aoff = lds_byte(wr * 64 + fr, fq * 8), boff = lds_byte(wc * 32 + fr, fq * 8);
#define PG8_SA(b, h) (((b) * 2 + (h)) * HTB)
#define PG8_SB(b, h) ((4 + (b) * 2 + (h)) * HTB)
#define PG8_STAGE(bufoff, gbase, voff) do { _Pragma("unroll") for (int _i = 0; _i < 2; ++_i) \
        __builtin_amdgcn_global_load_lds((const unsigned*)((const char*)(gbase) + (voff)[_i]), (PG8_LAS unsigned*)(lds + (bufoff) + ldsw + _i * 8192), 16, 0, 0); } while (0)
#define PG8_LDA(dst, b, h) do { _Pragma("unroll") for (int m = 0; m < 4; ++m) _Pragma("unroll") for (int k = 0; k < 2; ++k) dst[m][k] = *(const PG8_LAS bf16x8*)(lds + PG8_SA(b, h) + aoff + m * 2048 + k * 1024); } while (0)
#define PG8_LDB(dst, b, h) do { _Pragma("unroll") for (int n = 0; n < 2; ++n) _Pragma("unroll") for (int k = 0; k < 2; ++k) dst[n][k] = *(const PG8_LAS bf16x8*)(lds + PG8_SB(b, h) + boff + n * 2048 + k * 1024); } while (0)
#define PG8_MMA(ai, bj, At, Bt) do { __builtin_amdgcn_s_setprio(1); _Pragma("unroll") for (int m = 0; m < 4; ++m) _Pragma("unroll") for (int n = 0; n < 2; ++n) _Pragma("unroll") for (int k = 0; k < 2; ++k) \
        acc[ai][bj][m][n] = __builtin_amdgcn_mfma_f32_16x16x32_bf16(Bt[n][k], At[m][k], acc[ai][bj][m][n], 0, 0, 0); __builtin_amdgcn_s_setprio(0); } while (0)
#define PG8_WAIT_V(n) asm volatile("s_waitcnt vmcnt(" #n ")" ::: "memory")
#define PG8_WAIT_L(n) asm volatile("s_waitcnt lgkmcnt(" #n ")" ::: "memory")
#define PG8_BAR __builtin_amdgcn_s_barrier()
#define PG8_SCHED __builtin_amdgcn_sched_barrier(0)
    Unit cur, nxt; int ui = 0;
    if (!S.next(0, cur)) return;
    f32x4 acc[2][2][4][2];
#pragma unroll
    for (int a = 0; a < 2; ++a)
#pragma unroll
        for (int b = 0; b < 2; ++b)
#pragma unroll
            for (int m = 0; m < 4; ++m)
#pragma unroll
                for (int n = 0; n < 2; ++n) acc[a][b][m][n] = (f32x4){0.f, 0.f, 0.f, 0.f};
    bf16x8 At[4][2], B0[2][2], B1[2][2];
    const char* cA = (const char*)g.A + (size_t)cur.pm * tstep; const char* cB = (const char*)g.Bt + (size_t)cur.pn * tstep;
    S.a_ready(cur);
    if constexpr (SP2) {
        PG8_STAGE(PG8_SB(0, 0), cB, voffB); PG8_STAGE(PG8_SB(0, 1), cB + hstep, voffB); PG8_STAGE(PG8_SA(0, 0), cA, voffA); PG8_STAGE(PG8_SA(0, 1), cA + hstep, voffA);
        if (wr == 1) PG8_BAR;
        PG8_WAIT_V(2); PG8_BAR;
        PG8_STAGE(PG8_SB(1, 0), cB + kstep, voffB); PG8_STAGE(PG8_SA(1, 0), cA + kstep, voffA); PG8_STAGE(PG8_SB(1, 1), cB + hstep + kstep, voffB);
        PG8_WAIT_V(6); PG8_BAR;
    } else {
        PG8_STAGE(PG8_SB(0, 0), cB, voffB); PG8_STAGE(PG8_SA(0, 0), cA, voffA); PG8_STAGE(PG8_SB(0, 1), cB + hstep, voffB); PG8_STAGE(PG8_SA(0, 1), cA + hstep, voffA);
        if (wr == 1) PG8_BAR;
        PG8_WAIT_V(4); PG8_BAR;
        PG8_STAGE(PG8_SB(1, 0), cB + kstep, voffB); PG8_STAGE(PG8_SA(1, 0), cA + kstep, voffA); PG8_STAGE(PG8_SB(1, 1), cB + hstep + kstep, voffB);
        PG8_WAIT_V(6); PG8_BAR;
    }
    for (;;) {
        const bool has_next = S.next(ui + 1, nxt);
        const char* nA = has_next ? (const char*)g.A + (size_t)nxt.pm * tstep : cA; const char* nB = has_next ? (const char*)g.Bt + (size_t)nxt.pn * tstep : cB;
        for (int t = 0; t < nt; t += 2) {
            const bool last = (t == nt - 2);
            const char* a1 = cA + (size_t)(t + 1) * kstep;
            const char* a2 = last ? nA : cA + (size_t)(t + 2) * kstep; const char* b2 = last ? nB : cB + (size_t)(t + 2) * kstep;
            const char* a3 = a2 + kstep; const char* b3 = b2 + kstep;
            if (last && has_next) S.a_ready(nxt);
            if constexpr (SP2) {
            PG8_LDB(B0, 0, 0); PG8_LDB(B1, 0, 1); PG8_SCHED; PG8_LDA(At, 0, 0); PG8_STAGE(PG8_SA(1, 1), a1 + hstep, voffA);
            PG8_WAIT_V(8); PG8_WAIT_L(0); PG8_BAR; PG8_MMA(0, 0, At, B0); PG8_MMA(0, 1, At, B1); PG8_BAR; PG8_SCHED;
            PG8_LDA(At, 0, 1); PG8_STAGE(PG8_SB(0, 0), b2, voffB); PG8_STAGE(PG8_SB(0, 1), b2 + hstep, voffB); PG8_STAGE(PG8_SA(0, 0), a2, voffA);
            PG8_WAIT_V(8); PG8_WAIT_L(0); PG8_BAR; PG8_MMA(1, 0, At, B0); PG8_MMA(1, 1, At, B1); PG8_BAR; PG8_SCHED;
            PG8_LDB(B0, 1, 0); PG8_LDB(B1, 1, 1); PG8_SCHED; PG8_LDA(At, 1, 0); PG8_STAGE(PG8_SA(0, 1), a2 + hstep, voffA);
            PG8_WAIT_V(8); PG8_WAIT_L(0); PG8_BAR; PG8_MMA(0, 0, At, B0); PG8_MMA(0, 1, At, B1); PG8_BAR; PG8_SCHED;
            PG8_LDA(At, 1, 1); PG8_STAGE(PG8_SB(1, 0), b3, voffB); PG8_STAGE(PG8_SB(1, 1), b3 + hstep, voffB); PG8_STAGE(PG8_SA(1, 0), a3, voffA);
            PG8_WAIT_V(8); PG8_WAIT_L(0); PG8_BAR; PG8_MMA(1, 0, At, B0); PG8_MMA(1, 1, At, B1); PG8_BAR; PG8_SCHED;
            } else {
            PG8_LDB(B0, 0, 0); PG8_SCHED; PG8_LDA(At, 0, 0); PG8_STAGE(PG8_SA(1, 1), a1 + hstep, voffA);
            PG8_WAIT_L(8); PG8_BAR; PG8_WAIT_L(0); PG8_MMA(0, 0, At, B0); PG8_BAR; PG8_SCHED;
            PG8_LDB(B1, 0, 1); PG8_STAGE(PG8_SB(0, 0), b2, voffB);
            PG8_BAR; PG8_WAIT_L(0); PG8_MMA(0, 1, At, B1); PG8_BAR;
            PG8_LDA(At, 0, 1); PG8_STAGE(PG8_SA(0, 0), a2, voffA);
            PG8_BAR; PG8_WAIT_L(0); PG8_MMA(1, 0, At, B0); PG8_BAR; PG8_SCHED;
            PG8_STAGE(PG8_SB(0, 1), b2 + hstep, voffB);
            PG8_WAIT_V(6); PG8_BAR; PG8_MMA(1, 1, At, B1); PG8_BAR;
            PG8_LDB(B0, 1, 0); PG8_SCHED; PG8_LDA(At, 1, 0); PG8_STAGE(PG8_SA(0, 1), a2 + hstep, voffA);
            PG8_WAIT_L(8); PG8_BAR; PG8_WAIT_L(0); PG8_MMA(0, 0, At, B0); PG8_BAR; PG8_SCHED;
            PG8_LDB(B1, 1, 1); PG8_STAGE(PG8_SB(1, 0), b3, voffB);
            PG8_BAR; PG8_WAIT_L(0); PG8_MMA(0, 1, At, B1); PG8_BAR;
            PG8_LDA(At, 1, 1); PG8_STAGE(PG8_SA(1, 0), a3, voffA);
            PG8_BAR; PG8_WAIT_L(0); PG8_MMA(1, 0, At, B0); PG8_BAR; PG8_SCHED;
            PG8_STAGE(PG8_SB(1, 1), b3 + hstep, voffB);
            PG8_WAIT_V(6); PG8_BAR; PG8_MMA(1, 1, At, B1); PG8_BAR;
            }
        }
        if constexpr (ALIGN_EPI) { if (wr == 0) PG8_BAR; }
        if constexpr (!Epi::AFTER_DRAIN) { E(acc, cur, wr, wc, fr, fq); S.done(cur); }
        if (!has_next) break;
#pragma unroll
        for (int a = 0; a < 2; ++a)
#pragma unroll
            for (int b = 0; b < 2; ++b)
#pragma unroll
                for (int m = 0; m < 4; ++m)
#pragma unroll
                    for (int n = 0; n < 2; ++n) acc[a][b][m][n] = (f32x4){0.f, 0.f, 0.f, 0.f};
        cur = nxt; cA = nA; cB = nB; ++ui;
        if constexpr (ALIGN_EPI) { if (wr == 1) PG8_BAR; }
    }
    PG8_WAIT_V(0);
    if constexpr (!ALIGN_EPI) { if (wr == 0) PG8_BAR; }
    PG8_BAR;
    if constexpr (Epi::AFTER_DRAIN) { E.fused(acc, cur, wr, wc, fr, fq, lds, wid, lane); S.done(cur); }
#undef PG8_SA
#undef PG8_SB
#undef PG8_STAGE
#undef PG8_LDA
#undef PG8_LDB
#undef PG8_MMA
#undef PG8_WAIT_V
#undef PG8_WAIT_L
#undef PG8_BAR
#undef PG8_SCHED
}
}

__device__ __forceinline__ void ph_mod_partial(const Params& P, unsigned char* lds) {
    const int lane = threadIdx.x & 63, wave = __builtin_amdgcn_readfirstlane(threadIdx.x >> 6);
    const int gw = blockIdx.x * NWV + wave, NGW = gridDim.x * NWV;
    float* modp = (float*)(P.ws + WS_MODP);
    float* ca = (float*)(lds + 131072);
    for (int e = threadIdx.x; e < 2 * DM; e += NTHR) ca[e] = silu_f(P.c[e]);
    __syncthreads();
    for (int it = gw; it < 144 * 16; it += NGW) {
        const int cgp = it % 144, ks = it / 144, n = cgp * 64 + lane;
        float a0 = 0.f, a1 = 0.f;
        const float* wp = P.w_ada + (size_t)(ks * 64) * NMODC + n;
#pragma unroll 16
        for (int kk = 0; kk < 64; ++kk) {
            const float w = wp[(size_t)kk * NMODC];
            a0 += ca[ks * 64 + kk] * w; a1 += ca[DM + ks * 64 + kk] * w;
        }
        modp[(size_t)(ks * 2 + 0) * NMODC + n] = a0; modp[(size_t)(ks * 2 + 1) * NMODC + n] = a1;
    }
}

template <bool FRAG = false>
__device__ __forceinline__ void tr_item(const float* W, int K, int N, bf16_t* WT, int dest_row0, float* scr, int k0, int n0, int lane) {
    const int nn = n0 + (lane & 31); const bool ok = nn < N;
#pragma unroll
    for (int i = 0; i < 32; ++i) { const int kk = 2 * i + (lane >> 5); scr[kk * 33 + (lane & 31)] = ok ? W[(size_t)(k0 + kk) * N + nn] : 0.f; }
    WSYNC();
    const int c = lane & 7;
#pragma unroll
    for (int j = 0; j < 4; ++j) { const int n = (lane >> 3) + 8 * j; const float* sp = scr + (8 * c) * 33 + n;
        u32x4 o; o.x = pk2(sp[0 * 33], sp[1 * 33]); o.y = pk2(sp[2 * 33], sp[3 * 33]); o.z = pk2(sp[4 * 33], sp[5 * 33]); o.w = pk2(sp[6 * 33], sp[7 * 33]);
        if (FRAG) { const int nn2 = dest_row0 + n, kk2 = k0 + 8 * c;
            *(u32x4*)(WT + ((size_t)(((nn2 >> 5) * (K >> 4) + (kk2 >> 4)) * 64 + ((kk2 >> 3) & 1) * 32 + (nn2 & 31)) << 3)) = o; }
        else *(u32x4*)(WT + (size_t)(dest_row0 + n) * K + k0 + 8 * c) = o; }
    WSYNC();
}
__device__ __forceinline__ void ph_weights(const Params& P, unsigned char* lds) {
    const int lane = threadIdx.x & 63, wave = __builtin_amdgcn_readfirstlane(threadIdx.x >> 6);
    const int gw = blockIdx.x * NWV + wave, NGW = gridDim.x * NWV;
    float* scr = (float*)(lds + wave * 16384);
    constexpr int I_GU = 16 * 88, I_D = 44 * 32, I_IN = 16 * 96, I_OUT = 16 * 32, I_C1 = 32 * 8, I_C2 = 4 * 2, I_B1 = 2 * 32 * 4;
    constexpr int NIT = 4 * I_GU + 2 * I_D + I_IN + I_OUT + 2 * I_C1 + 2 * I_C2 + I_B1;
    for (int it = gw; it < NIT; it += NGW) {
        int r = it;
        if (r < 4 * I_GU) {
            const int w = r / I_GU; r -= w * I_GU; const int kb = r / 88, nb = r % 88, n0 = nb * 32;
            const float* W = (w == 0) ? P.w1g : (w == 1) ? P.w1u : (w == 2) ? P.w2g : P.w2u;
            bf16_t* WT = (bf16_t*)(P.ws + ((w < 2) ? WS_W1GU : WS_W2GU));
            tr_item(W, DM, DFF, WT, 256 * (n0 >> 7) + (n0 & 127) + ((w & 1) ? 128 : 0), scr, kb * 64, n0, lane);
            continue;
        }
        r -= 4 * I_GU;
        if (r < 2 * I_D) {
            const int w = r / I_D; r -= w * I_D; const int kb = r / 32, nb = r % 32;
            tr_item(w ? P.w2d : P.w1d, DFF, DM, (bf16_t*)(P.ws + (w ? WS_W2D : WS_W1D)), nb * 32, scr, kb * 64, nb * 32, lane);
            continue;
        }
        r -= 2 * I_D;
        if (r < I_IN) { const int kb = r / 96, nb = r % 96; tr_item(P.w_in, DM, INW, (bf16_t*)(P.ws + WS_WIN), nb * 32, scr, kb * 64, nb * 32, lane); continue; }
        r -= I_IN;
        if (r < I_OUT) { const int kb = r / 32, nb = r % 32; tr_item(P.w_out, DM, DM, (bf16_t*)(P.ws + WS_WOUT), nb * 32, scr, kb * 64, nb * 32, lane); continue; }
        r -= I_OUT;
        if (r < 2 * I_C1) { const int X = r / I_C1; r -= X * I_C1; const int kb = r / 8, nb = r % 8;
            tr_item<true>(X ? P.wcv1 : P.wck1, 2048, 256, (bf16_t*)(P.ws + (X ? WS_WC1V : WS_WC1K)), nb * 32, scr, kb * 64, nb * 32, lane); continue; }
        r -= 2 * I_C1;
        if (r < 2 * I_C2) { const int X = r / I_C2; r -= X * I_C2; const int kb = r / 2, nb = r % 2;
            tr_item(X ? P.wcv2 : P.wck2, 256, 64, (bf16_t*)(P.ws + (X ? WS_WC2V : WS_WC2K)), nb * 32, scr, kb * 64, nb * 32, lane); continue; }
        r -= 2 * I_C2;
        {
            const int X = r >> 7, ks = (r >> 2) & 31, n = (r & 3) * 64 + lane;
            const float* W1 = X ? P.wcv1 : P.wck1; const float* pe = X ? P.cpv : P.cpk;
            float a = 0.f;
            for (int kk = 0; kk < 64; ++kk) { const int k = ks * 64 + kk; a += pe[k] * W1[(size_t)k * 256 + n]; }
            ((float*)(P.ws + WS_B1P))[(X * 32 + ks) * 256 + n] = a;
        }
    }
}

__device__ __forceinline__ void ph_bias_gemv(const Params& P, const bf16_t* Wt, int N, int idx_shift) {
    const int lane = threadIdx.x & 63, wave = __builtin_amdgcn_readfirstlane(threadIdx.x >> 6);
    const int gw = blockIdx.x * NWV + wave, NGW = gridDim.x * NWV;
    const float* mod = (const float*)(P.ws + WS_MOD);
    float* bias = (float*)(P.ws + WS_BIAS);
    float s0[16], s1[16];
#pragma unroll
    for (int q = 0; q < 4; ++q) { const f32x4 a = *(const f32x4*)(mod + idx_shift * DM + lane * 16 + q * 4), b = *(const f32x4*)(mod + NMODC + idx_shift * DM + lane * 16 + q * 4);
        s0[4 * q] = a[0]; s0[4 * q + 1] = a[1]; s0[4 * q + 2] = a[2]; s0[4 * q + 3] = a[3]; s1[4 * q] = b[0]; s1[4 * q + 1] = b[1]; s1[4 * q + 2] = b[2]; s1[4 * q + 3] = b[3]; }
    for (int n = gw; n < N; n += NGW) {
        float w[16]; { float t[8]; ld8(Wt + (size_t)n * DM + lane * 16, t);
#pragma unroll
            for (int e2 = 0; e2 < 8; ++e2) w[e2] = t[e2];
            ld8(Wt + (size_t)n * DM + lane * 16 + 8, t);
#pragma unroll
            for (int e2 = 0; e2 < 8; ++e2) w[8 + e2] = t[e2]; }
        float a0 = 0.f, a1 = 0.f;
#pragma unroll
        for (int e2 = 0; e2 < 16; ++e2) { a0 += s0[e2] * w[e2]; a1 += s1[e2] * w[e2]; }
        a0 = wave_sum(a0); a1 = wave_sum(a1);
        if (lane == 0) { bias[n] = a0; bias[N + n] = a1; }
    }
}
__device__ __forceinline__ void ph_norm(const Params& P, unsigned char* lds, const float* src, const float* g, int idx_shift, bool from_partials) {
    const int tid = threadIdx.x, lane = tid & 63, wave = __builtin_amdgcn_readfirstlane(tid >> 6);
    float* sh = (float*)lds;
    const float* modp = (const float*)(P.ws + WS_MODP);
    float* mod = (float*)(P.ws + WS_MOD);
    bf16_t* dst = (bf16_t*)(P.ws + WS_XN);
    if (from_partials) {
        for (int e = blockIdx.x * NTHR + tid; e < 2 * NMODC; e += gridDim.x * NTHR) {
            const int b = e / NMODC, n = e % NMODC; float v = P.b_ada[n];
            for (int ks = 0; ks < 16; ++ks) v += modp[(size_t)(ks * 2 + b) * NMODC + n];
            mod[e] = v;
        }
    }
    for (int chunk = blockIdx.x; chunk < 256; chunk += gridDim.x) {
        const int b = chunk / 128;
        __syncthreads();
        for (int ci = tid; ci < 2048; ci += NTHR) {
            const int n = idx_shift * DM + ci; float v;
            if (from_partials) { v = P.b_ada[n]; for (int ks = 0; ks < 16; ++ks) v += modp[(size_t)(ks * 2 + b) * NMODC + n]; }
            else v = mod[b * NMODC + n];
            sh[ci] = v;
        }
        __syncthreads();
        for (int r = 0; r < 8; r += 4) {
            const int row = chunk * 64 + wave * 8 + r;
            f32x4 v[4][4]; float ss[4];
#pragma unroll
            for (int q = 0; q < 4; ++q) { const f32x4* xr = (const f32x4*)(src + (size_t)(row + q) * DM) + lane;
#pragma unroll
                for (int j = 0; j < 4; ++j) v[q][j] = xr[64 * j]; }
#pragma unroll
            for (int q = 0; q < 4; ++q) { float a = 0.f;
#pragma unroll
                for (int j = 0; j < 4; ++j) a += (v[q][j].x * v[q][j].x + v[q][j].y * v[q][j].y) + (v[q][j].z * v[q][j].z + v[q][j].w * v[q][j].w);
                ss[q] = a; }
#pragma unroll
            for (int o2 = 1; o2 < 64; o2 <<= 1) {
#pragma unroll
                for (int q = 0; q < 4; ++q) ss[q] += __shfl_xor(ss[q], o2); }
#pragma unroll
            for (int j = 0; j < 4; ++j) {
                const int col = 256 * j + 4 * lane;
                const f32x4 gg = *(const f32x4*)(g + col), s4 = *(const f32x4*)(sh + col), c4 = *(const f32x4*)(sh + 1024 + col);
                const f32x4 gm = gg * (c4 + 1.0f);
#pragma unroll
                for (int q = 0; q < 4; ++q) {
                    const float rstd = 1.0f / sqrtf(ss[q] * (1.0f / DM) + EPS);
                    const f32x4 o = v[q][j] * rstd * gm + s4;
                    u32x2 w; w.x = pk2(o.x, o.y); w.y = pk2(o.z, o.w);
                    *(u32x2*)(dst + (size_t)(row + q) * DM + col) = w;
                }
            }
        }
    }
}
__device__ __forceinline__ void ph_final_norm(const Params& P) {
    const int lane = threadIdx.x & 63, wave = __builtin_amdgcn_readfirstlane(threadIdx.x >> 6);
    const int gw = blockIdx.x * NWV + wave, NGW = gridDim.x * NWV;
    f32x4 gg[4];
#pragma unroll
    for (int j = 0; j < 4; ++j) gg[j] = *(const f32x4*)(P.g_final + 256 * j + 4 * lane);
    for (int row0 = gw * 4; row0 < T; row0 += NGW * 4) {
        f32x4 v[4][4]; float ss[4];
#pragma unroll
        for (int q = 0; q < 4; ++q) { const f32x4* xr = (const f32x4*)(P.out + (size_t)(row0 + q) * DM) + lane;
#pragma unroll
            for (int j = 0; j < 4; ++j) v[q][j] = xr[64 * j]; }
#pragma unroll
        for (int q = 0; q < 4; ++q) { float a = 0.f;
#pragma unroll
            for (int j = 0; j < 4; ++j) a += (v[q][j].x * v[q][j].x + v[q][j].y * v[q][j].y) + (v[q][j].z * v[q][j].z + v[q][j].w * v[q][j].w);
            ss[q] = a; }
#pragma unroll
        for (int o2 = 1; o2 < 64; o2 <<= 1) {
#pragma unroll
            for (int q = 0; q < 4; ++q) ss[q] += __shfl_xor(ss[q], o2); }
#pragma unroll
        for (int q = 0; q < 4; ++q) { const float rstd = 1.0f / sqrtf(ss[q] * (1.0f / DM) + EPS);
            f32x4* xr = (f32x4*)(P.out + (size_t)(row0 + q) * DM) + lane;
#pragma unroll
            for (int j = 0; j < 4; ++j) xr[64 * j] = v[q][j] * rstd * gg[j]; }
    }
}

__device__ __forceinline__ int ktile_off(int kv, int d) {
    const int j = kv >> 6, kl = kv & 63, mb = kl >> 5, r32 = kl & 31, ds = d >> 4, hi = (d >> 3) & 1, e = d & 7;
    return j * 4096 + (((mb * 4 + ds) * 64 + hi * 32 + r32) << 3) + e;
}
__device__ __forceinline__ int vtile_off(int kv, int d) {
    const int j = kv >> 6, kl = kv & 63, ks = kl >> 4, w = kl & 15, hi = (w >> 2) & 1, e = (w & 3) | ((w >> 3) << 2), d0 = d >> 5, r32 = d & 31;
    return j * 4096 + (((d0 * 4 + ks) * 64 + hi * 32 + r32) << 3) + e;
}
__device__ __forceinline__ void up8(const u32x4 w, float (&v)[8]) {
    v[0] = bf2f(w.x & 0xffffu); v[1] = bf2f(w.x >> 16); v[2] = bf2f(w.y & 0xffffu); v[3] = bf2f(w.y >> 16);
    v[4] = bf2f(w.z & 0xffffu); v[5] = bf2f(w.z >> 16); v[6] = bf2f(w.w & 0xffffu); v[7] = bf2f(w.w >> 16);
}
__device__ __forceinline__ void vtile_item(const Params& P, unsigned char* lds, int it, int lane, int wave);
__device__ __forceinline__ void ph_post(const Params& P, unsigned char* lds) {
    const int lane = threadIdx.x & 63, wave = __builtin_amdgcn_readfirstlane(threadIdx.x >> 6);
    const bf16_t* PROJ = (const bf16_t*)(P.ws + WS_BIG);
    bf16_t* Y = (bf16_t*)(P.ws + WS_Y);
    bf16_t* Qr = (bf16_t*)(P.ws + WS_Q);
    const int ch = lane * 8, chunk = lane & 7;
    float w0[8], w1[8], w2[8], gc[8];
#pragma unroll
    for (int e = 0; e < 8; ++e) { w0[e] = P.conv_w[ch + e]; w1[e] = P.conv_w[512 + ch + e]; w2[e] = P.conv_w[1024 + ch + e]; gc[e] = P.goc[ch + e]; }
    const bool act1 = lane < 32;
    constexpr int CHT = 4, NCH = T / CHT;
    const int G = (int)gridDim.x, ncb = (G < 128) ? G : 128, blk = (int)blockIdx.x;
    const int wgt = (blk < ncb) ? 1 : 3;
    const int cstart = (blk < ncb) ? (blk * NWV + wave) : (ncb * NWV + ((blk - ncb) * NWV + wave) * 3);
    const int cstride = NWV * (ncb + 3 * (G - ncb));
    if (G > ncb) { if (blk >= ncb) for (int v = (blk - ncb) * NWV + wave; v < 1024; v += (G - ncb) * NWV) vtile_item(P, lds, v, lane, wave); }
    else for (int v = blk * NWV + wave; v < 1024; v += G * NWV) vtile_item(P, lds, v, lane, wave);
    for (int c0 = cstart; c0 < NCH; c0 += cstride)
    for (int cc = 0; cc < wgt; ++cc) {
        const int cidx = c0 + cc; if (cidx >= NCH) break;
        const int t0 = cidx * CHT;
        const int b = t0 / SEQ, sb = t0 % SEQ;
        const bf16_t* pr = PROJ + (size_t)t0 * PJ;
        float u1[8], u2[8];
#pragma unroll
        for (int e = 0; e < 8; ++e) { u1[e] = 0.f; u2[e] = 0.f; }
        if (sb >= 2) {
            float c1[8], x1[8], c2[8], x2[8];
            up8(*(const u32x4*)(pr - PJ + C_CC + ch), c1); up8(*(const u32x4*)(pr - PJ + C_CX + ch), x1);
            up8(*(const u32x4*)(pr - 2 * PJ + C_CC + ch), c2); up8(*(const u32x4*)(pr - 2 * PJ + C_CX + ch), x2);
#pragma unroll
            for (int e = 0; e < 8; ++e) { u1[e] = c1[e] * x1[e]; u2[e] = c2[e] * x2[e]; }
        }
        const u32x4 zz = {0u, 0u, 0u, 0u};
        u32x4 rcb = *(const u32x4*)(pr + C_CB + ch), rcc = *(const u32x4*)(pr + C_CC + ch), rcx = *(const u32x4*)(pr + C_CX + ch), rq = *(const u32x4*)(pr + C_Q + ch);
        u32x4 rk0 = *(const u32x4*)(pr + C_KV + ch), rk1 = act1 ? *(const u32x4*)(pr + C_KV + 512 + ch) : zz;
        for (int i = 0; i < CHT; ++i) {
            const int tok = t0 + i, s = sb + i;
            const u32x4 ccb = rcb, ccc = rcc, ccx = rcx, cq = rq, ck0 = rk0, ck1 = rk1;
            if (i < CHT - 1) { const bf16_t* pn = pr + (size_t)(i + 1) * PJ;
                rcb = *(const u32x4*)(pn + C_CB + ch); rcc = *(const u32x4*)(pn + C_CC + ch); rcx = *(const u32x4*)(pn + C_CX + ch); rq = *(const u32x4*)(pn + C_Q + ch);
                rk0 = *(const u32x4*)(pn + C_KV + ch); rk1 = act1 ? *(const u32x4*)(pn + C_KV + 512 + ch) : zz; }
            {
                float cb[8], c0[8], x0[8]; up8(ccb, cb); up8(ccc, c0); up8(ccx, x0);
                float y[8]; float ss = 0.f;
#pragma unroll
                for (int e = 0; e < 8; ++e) {
                    const float u0 = c0[e] * x0[e];
                    const float v = w0[e] * u2[e] + w1[e] * u1[e] + w2[e] * u0;
                    u2[e] = u1[e]; u1[e] = u0;
                    y[e] = cb[e] * v; ss += y[e] * y[e];
                }
                ss += __shfl_xor(ss, 1); ss += __shfl_xor(ss, 2); ss += __shfl_xor(ss, 4);
                const float rstd = 1.0f / sqrtf(ss * (1.0f / 64.0f) + EPS);
#pragma unroll
                for (int e = 0; e < 8; ++e) y[e] = y[e] * rstd * gc[e];
                st8(Y + (size_t)tok * DM + ch, y);
            }
            float cs[8], sn[8];
            {
                const float pf = (float)P.pos[tok];
#pragma unroll
                for (int e = 0; e < 8; ++e) {
                    constexpr float FRQ[8] = {1.0f, 0.1939227432012558f, 0.03760603070259094f, 0.007292664609849453f, 0.0014142135623842478f, 0.00027424818836152554f, 5.3182957344688475e-05f, 1.0313385246263351e-05f};
                    const float ang = pf * FRQ[e];
                    const double rev = (double)ang * 0.15915494309189535;
                    const float fx = (float)(rev - floor(rev));
                    cs[e] = __builtin_amdgcn_cosf(fx); sn[e] = __builtin_amdgcn_sinf(fx);
                }
            }
            {
                float qv[8], pv[8]; up8(cq, qv);
#pragma unroll
                for (int e = 0; e < 8; ++e) pv[e] = __shfl_xor(qv[e], 1);
#pragma unroll
                for (int e = 0; e < 8; ++e) {
                    float r = qv[e];
                    if (chunk == 0) r = qv[e] * cs[e] - pv[e] * sn[e];
                    else if (chunk == 1) r = qv[e] * cs[e] + pv[e] * sn[e];
                    qv[e] = r * QSCALE;
                }
                st8(Qr + (size_t)tok * 512 + ch, qv);
            }
#pragma unroll
            for (int p = 0; p < 2; ++p) {
                const int slot = p * 64 + lane, tensor = slot >> 4, g = (slot >> 3) & 1;
                const bool act = slot < 96;
                float kv[8], pv[8]; up8(p ? ck1 : ck0, kv);
#pragma unroll
                for (int e = 0; e < 8; ++e) pv[e] = __shfl_xor(kv[e], 1);
                if ((tensor & 1) == 0) {
#pragma unroll
                    for (int e = 0; e < 8; ++e) {
                        if (chunk == 0) kv[e] = kv[e] * cs[e] - pv[e] * sn[e];
                        else if (chunk == 1) kv[e] = kv[e] * cs[e] + pv[e] * sn[e];
                    }
                }
                if (act) {
                    bf16_t* base = (bf16_t*)(P.ws + WS_KV + (size_t)tensor * 4 * MiB) + (size_t)(b * 2 + g) * SEQ * 64;
                    if (tensor >= 2 && (tensor & 1) == 0) st8(base + ktile_off(s, chunk * 8), kv);
                }
            }
        }
    }
}

__device__ __forceinline__ void vtile_item(const Params& P, unsigned char* lds, int it, int lane, int wave) {
    const bf16_t* PROJ = (const bf16_t*)(P.ws + WS_BIG);
    bf16_t* tl = (bf16_t*)(lds + wave * 16384);
    const int r32 = lane & 31, hi = lane >> 5;
    {
        const int j = it & 127, bg = (it >> 7) & 3, tv = it >> 9;
        const int b = bg >> 1, g = bg & 1, tensor = 3 + 2 * tv;
        const bf16_t* src = PROJ + (size_t)(b * SEQ + j * 64 + lane) * PJ + C_KV + tensor * 128 + g * 64;
        WSYNC();
#pragma unroll
        for (int c = 0; c < 8; ++c) { const u32x4 v = *(const u32x4*)(src + c * 8);
            unsigned* d = (unsigned*)(tl + lane * 66 + c * 8); d[0] = v.x; d[1] = v.y; d[2] = v.z; d[3] = v.w; }
        WSYNC();
        bf16_t* dst = (bf16_t*)(P.ws + WS_KV + (size_t)tensor * 4 * MiB) + (size_t)bg * SEQ * 64 + (size_t)j * 4096;
#pragma unroll
        for (int f = 0; f < 8; ++f) {
            const int d = 32 * (f >> 2) + r32, kb = 16 * (f & 3) + 4 * hi;
            unsigned w[4];
#pragma unroll
            for (int q = 0; q < 4; ++q) { const int e0 = 2 * q, k0 = kb + (e0 & 3) + 8 * (e0 >> 2);
                w[q] = (unsigned)tl[k0 * 66 + d] | ((unsigned)tl[(k0 + 1) * 66 + d] << 16); }
            u32x4 o; o.x = w[0]; o.y = w[1]; o.z = w[2]; o.w = w[3];
            *(u32x4*)(dst + ((f * 64 + lane) << 3)) = o;
        }
    }
}
typedef short bf16x8 __attribute__((ext_vector_type(8)));
typedef float f32x16 __attribute__((ext_vector_type(16)));
typedef float f32x2_t __attribute__((ext_vector_type(2)));
typedef __bf16 bf16x2_t __attribute__((ext_vector_type(2)));
__device__ __forceinline__ unsigned cvtpk(float lo, float hi) { f32x2_t v = {lo, hi}; bf16x2_t b = __builtin_convertvector(v, bf16x2_t); return __builtin_bit_cast(unsigned, b); }
__device__ __forceinline__ float quad_sum(float v) {
    v += __builtin_bit_cast(float, __builtin_amdgcn_update_dpp(0, __builtin_bit_cast(int, v), 0xB1, 0xF, 0xF, true));
    v += __builtin_bit_cast(float, __builtin_amdgcn_update_dpp(0, __builtin_bit_cast(int, v), 0x4E, 0xF, 0xF, true));
    return v;
}
typedef const __attribute__((address_space(1))) char* gcptr;
__device__ __forceinline__ gcptr uni_ptr(const void* p) {
    const unsigned long long v = (unsigned long long)p;
    const unsigned lo = (unsigned)__builtin_amdgcn_readfirstlane((int)(unsigned)v), hi = (unsigned)__builtin_amdgcn_readfirstlane((int)(unsigned)(v >> 32));
    return (gcptr)(((unsigned long long)hi << 32) | lo);
}
__device__ __forceinline__ void ld_frags(bf16x8 (&f)[8], const bf16_t* tile, int lane) {
    gcptr b = uni_ptr(tile); const unsigned vo = (unsigned)lane * 16u;
#pragma unroll
    for (int i = 0; i < 8; ++i) f[i] = *(const __attribute__((address_space(1))) bf16x8*)(b + vo + i * 1024);
}
__device__ __forceinline__ void qk_tile(f32x16& s0, f32x16& s1, const bf16x8 (&kf)[8], const bf16x8 (&qf)[4]) {
    const f32x16 z = {0.f, 0.f, 0.f, 0.f, 0.f, 0.f, 0.f, 0.f, 0.f, 0.f, 0.f, 0.f, 0.f, 0.f, 0.f, 0.f};
    s0 = z; s1 = z;
    __builtin_amdgcn_s_setprio(1);
#pragma unroll
    for (int ds = 0; ds < 4; ++ds) {
        s0 = __builtin_amdgcn_mfma_f32_32x32x16_bf16(kf[ds], qf[ds], s0, 0, 0, 0);
        s1 = __builtin_amdgcn_mfma_f32_32x32x16_bf16(kf[4 + ds], qf[ds], s1, 0, 0, 0);
    }
    __builtin_amdgcn_s_setprio(0);
}
__device__ __forceinline__ void pv_tile(f32x16 (&o)[2], const f32x16& p0, const f32x16& p1, const bf16x8 (&vf)[8]) {
    u32x4 w0, w1, w2, w3;
    w0.x = cvtpk(p0[0], p0[1]); w0.y = cvtpk(p0[2], p0[3]); w0.z = cvtpk(p0[4], p0[5]); w0.w = cvtpk(p0[6], p0[7]);
    w1.x = cvtpk(p0[8], p0[9]); w1.y = cvtpk(p0[10], p0[11]); w1.z = cvtpk(p0[12], p0[13]); w1.w = cvtpk(p0[14], p0[15]);
    w2.x = cvtpk(p1[0], p1[1]); w2.y = cvtpk(p1[2], p1[3]); w2.z = cvtpk(p1[4], p1[5]); w2.w = cvtpk(p1[6], p1[7]);
    w3.x = cvtpk(p1[8], p1[9]); w3.y = cvtpk(p1[10], p1[11]); w3.z = cvtpk(p1[12], p1[13]); w3.w = cvtpk(p1[14], p1[15]);
    const bf16x8 b0 = __builtin_bit_cast(bf16x8, w0), b1 = __builtin_bit_cast(bf16x8, w1), b2 = __builtin_bit_cast(bf16x8, w2), b3 = __builtin_bit_cast(bf16x8, w3);
    __builtin_amdgcn_s_setprio(1);
#pragma unroll
    for (int d0 = 0; d0 < 2; ++d0) {
        o[d0] = __builtin_amdgcn_mfma_f32_32x32x16_bf16(vf[d0 * 4 + 0], b0, o[d0], 0, 0, 0);
        o[d0] = __builtin_amdgcn_mfma_f32_32x32x16_bf16(vf[d0 * 4 + 1], b1, o[d0], 0, 0, 0);
        o[d0] = __builtin_amdgcn_mfma_f32_32x32x16_bf16(vf[d0 * 4 + 2], b2, o[d0], 0, 0, 0);
        o[d0] = __builtin_amdgcn_mfma_f32_32x32x16_bf16(vf[d0 * 4 + 3], b3, o[d0], 0, 0, 0);
    }
    __builtin_amdgcn_s_setprio(0);
}
__device__ __forceinline__ float xhalf_max(float v) {
    const auto rr = __builtin_amdgcn_permlane32_swap(__float_as_uint(v), __float_as_uint(v), false, false);
    return fmaxf(__uint_as_float(rr[0]), __uint_as_float(rr[1]));
}
__device__ __forceinline__ float xhalf_sum(float v) {
    const auto rr = __builtin_amdgcn_permlane32_swap(__float_as_uint(v), __float_as_uint(v), false, false);
    return __uint_as_float(rr[0]) + __uint_as_float(rr[1]);
}
__device__ __forceinline__ void smax_step(f32x16& s0, f32x16& s1, float& m, float& l, f32x16 (&o)[2], bool sel) {
    float x0 = fmaxf(s0[0], s1[0]), x1 = fmaxf(s0[1], s1[1]), x2 = fmaxf(s0[2], s1[2]), x3 = fmaxf(s0[3], s1[3]);
#pragma unroll
    for (int r = 4; r < 16; r += 4) {
        x0 = fmaxf(x0, fmaxf(s0[r], s1[r])); x1 = fmaxf(x1, fmaxf(s0[r + 1], s1[r + 1])); x2 = fmaxf(x2, fmaxf(s0[r + 2], s1[r + 2])); x3 = fmaxf(x3, fmaxf(s0[r + 3], s1[r + 3]));
    }
    float mx = fmaxf(fmaxf(x0, x1), fmaxf(x2, x3));
    if (!sel) mx = NEGV;
    mx = xhalf_max(mx);
    const float mn = fmaxf(m, mx);
    if (__any(mn > m)) { const float al = __builtin_amdgcn_exp2f(m - mn); l *= al; o[0] *= al; o[1] *= al; }
    m = mn;
    const float me = sel ? mn : 1e30f;
    float a0 = 0.f, a1 = 0.f, a2 = 0.f, a3 = 0.f;
#pragma unroll
    for (int r = 0; r < 16; r += 2) {
        s0[r] = __builtin_amdgcn_exp2f(s0[r] - me); s0[r + 1] = __builtin_amdgcn_exp2f(s0[r + 1] - me);
        s1[r] = __builtin_amdgcn_exp2f(s1[r] - me); s1[r + 1] = __builtin_amdgcn_exp2f(s1[r + 1] - me);
        a0 += s0[r]; a1 += s0[r + 1]; a2 += s1[r]; a3 += s1[r + 1];
    }
    l += (a0 + a1) + (a2 + a3);
}
template <int KIND>
__device__ __forceinline__ void tile_body(f32x16 (&o)[2], float& m, float& l, bf16x8 (&kf)[8], const bf16x8 (&qf)[4], const bf16_t* vtile, const bf16_t* knext, int lane,
                                          int j, int s, int s0, int cur, bool sel, int hi) {
    bf16x8 vf[8]; ld_frags(vf, vtile, lane);
    asm volatile("" ::: "memory"); __builtin_amdgcn_sched_barrier(0);
    f32x16 a0, a1; qk_tile(a0, a1, kf, qf);
    asm volatile("" ::: "memory"); __builtin_amdgcn_sched_barrier(0);
    ld_frags(kf, knext, lane);
    asm volatile("" ::: "memory"); __builtin_amdgcn_sched_barrier(0);
    const int pb = 64 * j + 4 * hi;
    if (KIND == 0) {
        if (j == cur) {
#pragma unroll
            for (int r = 0; r < 16; ++r) { const int pos = pb + (r & 3) + 8 * (r >> 2); a0[r] = (sel && pos <= s) ? a0[r] : NEGV; a1[r] = (sel && pos + 32 <= s) ? a1[r] : NEGV; }
        }
    } else {
        if (64 * j + 63 > s0 || 64 * j < s0 + 7 - 511) {
#pragma unroll
            for (int r = 0; r < 16; ++r) { const int pos = pb + (r & 3) + 8 * (r >> 2);
                a0[r] = (pos <= s && pos >= s - 511) ? a0[r] : NEGV; a1[r] = (pos + 32 <= s && pos + 32 >= s - 511) ? a1[r] : NEGV; }
        }
    }
    smax_step(a0, a1, m, l, o, KIND == 0 ? sel : true);
    pv_tile(o, a0, a1, vf);
}
__device__ __forceinline__ int next_blk(unsigned& bits, int& w, unsigned U1, unsigned U2, unsigned U3) {
    while (bits == 0u && w < 3) { ++w; bits = (w == 1) ? U1 : (w == 2) ? U2 : U3; }
    if (bits == 0u) return -1;
    const int bp = __builtin_ctz(bits); bits &= bits - 1u; return 32 * w + bp;
}
__device__ __forceinline__ void attn_unit(const Params& P, float* impA, float* impB, int bg, int tg, int lane) {
    const int b = bg >> 1, g = bg & 1, s0 = tg * 8, r32 = lane & 31, hi = lane >> 5, tl = r32 >> 2, hh = r32 & 3;
    const int s = s0 + tl, tok = b * SEQ + s, cur = s0 >> 6;
    const bf16_t* PROJ = (const bf16_t*)(P.ws + WS_BIG);
    const bf16_t* Qr = (const bf16_t*)(P.ws + WS_Q);
    bf16_t* Y = (bf16_t*)(P.ws + WS_Y);
    const bf16_t* KCt = (const bf16_t*)(P.ws + WS_KCC) + (size_t)bg * 512 * 64;
    const bf16_t* VCt = (const bf16_t*)(P.ws + WS_VCC) + (size_t)bg * 512 * 64;
    const bf16_t* KSt = (const bf16_t*)(P.ws + WS_KV + 2 * 4 * MiB) + (size_t)bg * SEQ * 64;
    const bf16_t* VSt = (const bf16_t*)(P.ws + WS_KV + 3 * 4 * MiB) + (size_t)bg * SEQ * 64;
    const bf16_t* KWt = (const bf16_t*)(P.ws + WS_KV + 4 * 4 * MiB) + (size_t)bg * SEQ * 64;
    const bf16_t* VWt = (const bf16_t*)(P.ws + WS_KV + 5 * 4 * MiB) + (size_t)bg * SEQ * 64;
    bf16x8 qf[4];
    { const bf16_t* qp = Qr + (size_t)tok * 512 + (g * 4 + hh) * 64 + hi * 8;
#pragma unroll
      for (int ds = 0; ds < 4; ++ds) qf[ds] = *(const bf16x8*)(qp + ds * 16); }
    float g0, g1, g2;
    { const bf16_t* gp = PROJ + (size_t)tok * PJ + C_GT + g * 12 + hh * 3;
      g0 = 1.0f / (1.0f + __expf(-bf2f(gp[0]))); g1 = 1.0f / (1.0f + __expf(-bf2f(gp[1]))); g2 = 1.0f / (1.0f + __expf(-bf2f(gp[2]))); }
    const f32x16 z16 = {0.f, 0.f, 0.f, 0.f, 0.f, 0.f, 0.f, 0.f, 0.f, 0.f, 0.f, 0.f, 0.f, 0.f, 0.f, 0.f};
    f32x16 ocmp[2]; ocmp[0] = z16; ocmp[1] = z16;
    {
        const f32x4 z4 = {0.f, 0.f, 0.f, 0.f};
#pragma unroll
        for (int i = 0; i < 8; ++i) *(f32x4*)(impA + ((i * 64 + lane) << 2)) = z4;
    }
    WSYNC();
    const int sm = s0 + 7;
    int nvm = (sm >= 31) ? ((sm - 31) / 16 + 1) : 0; if (nvm > 511) nvm = 511;
    int nv = (s >= 31) ? ((s - 31) / 16 + 1) : 0; if (nv > 511) nv = 511;
    const int ntc = (nvm + 63) >> 6;
    int nvlo = (s0 >= 31) ? ((s0 - 31) / 16 + 1) : 0; if (nvlo > 511) nvlo = 511;
    if (ntc > 0) {
        float m = NEGV, l = 0.f;
        for (int c = 0; c < ntc; ++c) {
            bf16x8 kf[8]; ld_frags(kf, KCt + c * 4096, lane);
            f32x16 a0, a1; qk_tile(a0, a1, kf, qf);
            const int ib = 64 * c + 4 * hi;
            const bool full = 64 * (c + 1) <= nvlo;
            float mx = NEGV;
            if (!full) {
#pragma unroll
                for (int r = 0; r < 16; ++r) { const int i0 = ib + (r & 3) + 8 * (r >> 2); a0[r] = (i0 < nv) ? a0[r] : NEGV; a1[r] = (i0 + 32 < nv) ? a1[r] : NEGV; }
            }
#pragma unroll
            for (int r = 0; r < 16; ++r) mx = fmaxf(mx, fmaxf(a0[r], a1[r]));
            mx = xhalf_max(mx);
            const float mn = fmaxf(m, mx); l *= __builtin_amdgcn_exp2f(m - mn); m = mn;
            float sum = 0.f;
            if (full) {
#pragma unroll
                for (int r = 0; r < 16; ++r) sum += __builtin_amdgcn_exp2f(a0[r] - mn) + __builtin_amdgcn_exp2f(a1[r] - mn);
            } else {
#pragma unroll
                for (int r = 0; r < 16; ++r) { const int i0 = ib + (r & 3) + 8 * (r >> 2);
                    sum += ((i0 < nv) ? __builtin_amdgcn_exp2f(a0[r] - mn) : 0.f) + ((i0 + 32 < nv) ? __builtin_amdgcn_exp2f(a1[r] - mn) : 0.f); }
            }
            l += sum;
        }
        l = xhalf_sum(l);
        const float inv = (l > 0.f) ? 1.0f / l : 0.f;
        f32x16 o[2]; o[0] = z16; o[1] = z16;
        for (int c = 0; c < ntc; ++c) {
            bf16x8 kf[8], vf[8]; ld_frags(kf, KCt + c * 4096, lane); ld_frags(vf, VCt + c * 4096, lane);
            f32x16 a0, a1; qk_tile(a0, a1, kf, qf);
            const int ib = 64 * c + 4 * hi;
            if (64 * (c + 1) <= nvlo) {
#pragma unroll
                for (int r = 0; r < 16; ++r) { a0[r] = __builtin_amdgcn_exp2f(a0[r] - m) * inv; a1[r] = __builtin_amdgcn_exp2f(a1[r] - m) * inv; }
            } else {
#pragma unroll
                for (int r = 0; r < 16; ++r) { const int i0 = ib + (r & 3) + 8 * (r >> 2);
                    a0[r] = (i0 < nv) ? __builtin_amdgcn_exp2f(a0[r] - m) * inv : 0.f; a1[r] = (i0 + 32 < nv) ? __builtin_amdgcn_exp2f(a1[r] - m) * inv : 0.f; }
            }
#pragma unroll
            for (int rr = 0; rr < 4; ++rr) {
                float sa = (a0[4 * rr] + a0[4 * rr + 1]) + (a0[4 * rr + 2] + a0[4 * rr + 3]), sb = a0[4 * rr + 3];
                float ta = (a1[4 * rr] + a1[4 * rr + 1]) + (a1[4 * rr + 2] + a1[4 * rr + 3]), tb = a1[4 * rr + 3];
                sa = quad_sum(sa); sb = quad_sum(sb); ta = quad_sum(ta); tb = quad_sum(tb);
                const int j = 16 * c + 2 * rr + hi;
                if (hh == 0) { impA[tl * 128 + j] = sa; impB[tl * 128 + j + 1] = sb; impA[tl * 128 + j + 8] = ta; if (j + 9 < 128) impB[tl * 128 + j + 9] = tb; }
            }
            pv_tile(o, a0, a1, vf);
        }
        ocmp[0] = o[0] * g0; ocmp[1] = o[1] * g0;
    }
    WSYNC();
    unsigned U0 = 0u, U1 = 0u, U2 = 0u, U3 = 0u, mk0 = 0u, mk1 = 0u, mk2 = 0u, mk3 = 0u;
    {
        const unsigned long long lt = (lane == 0) ? 0ull : (~0ull >> (64 - lane));
        const int j0 = lane, j1 = lane + 64;
        const bool c0 = (j0 >= 1) && (j0 <= cur - 2), c1 = (j1 <= cur - 2);
        const bool f0 = (j0 == 0) || (j0 == cur) || (j0 == cur - 1), f1 = (j1 == cur) || (j1 == cur - 1);
        for (int t8 = 0; t8 < 8; ++t8) {
            bool sel0, sel1;
            if (cur - 2 <= 13) { sel0 = j0 <= cur; sel1 = j1 <= cur; }
            else {
                const float v0 = impA[t8 * 128 + j0] + impB[t8 * 128 + j0], v1 = impA[t8 * 128 + j1] + impB[t8 * 128 + j1];
                const unsigned k0 = c0 ? __float_as_uint(v0) : 0u, k1 = c1 ? __float_as_uint(v1) : 0u;
                unsigned Tt = 0u;
                for (int bit = 30; bit >= 0; --bit) {
                    const unsigned tr = Tt | (1u << bit);
                    const int cnt = __popcll(__ballot(k0 >= tr)) + __popcll(__ballot(k1 >= tr));
                    if (cnt >= 13) Tt = tr;
                    if (cnt == 13) break;
                }
                const bool gt0 = c0 && (k0 > Tt), gt1 = c1 && (k1 > Tt), eq0 = c0 && (k0 == Tt), eq1 = c1 && (k1 == Tt);
                const int rem = 13 - (__popcll(__ballot(gt0)) + __popcll(__ballot(gt1)));
                const unsigned long long e0 = __ballot(eq0), e1 = __ballot(eq1);
                const bool ch0 = gt0 || (eq0 && (__popcll(e0 & lt) < rem)), ch1 = gt1 || (eq1 && ((__popcll(e0) + __popcll(e1 & lt)) < rem));
                sel0 = f0 || ch0; sel1 = f1 || ch1;
            }
            const unsigned long long b0 = __ballot(sel0), b1 = __ballot(sel1);
            const unsigned w0 = (unsigned)b0, w1 = (unsigned)(b0 >> 32), w2 = (unsigned)b1, w3 = (unsigned)(b1 >> 32);
            U0 |= w0; U1 |= w1; U2 |= w2; U3 |= w3;
            if (tl == t8) { mk0 = w0; mk1 = w1; mk2 = w2; mk3 = w3; }
        }
    }
    WSYNC();
    float* stash = impA + lane;
#pragma unroll
    for (int r = 0; r < 16; ++r) { stash[r * 64] = ocmp[0][r]; stash[(16 + r) * 64] = ocmp[1][r]; }
    {
        float m = NEGV, l = 0.f; f32x16 o[2]; o[0] = z16; o[1] = z16;
        U0 = (unsigned)__builtin_amdgcn_readfirstlane((int)U0); U1 = (unsigned)__builtin_amdgcn_readfirstlane((int)U1);
        U2 = (unsigned)__builtin_amdgcn_readfirstlane((int)U2); U3 = (unsigned)__builtin_amdgcn_readfirstlane((int)U3);
        unsigned bits = U0; int w = 0;
        int j = next_blk(bits, w, U1, U2, U3);
        bf16x8 kf[8]; ld_frags(kf, KSt + (size_t)j * 4096, lane);
        while (j >= 0) {
            const int jn = next_blk(bits, w, U1, U2, U3);
            const unsigned mw = (j < 32) ? mk0 : (j < 64) ? mk1 : (j < 96) ? mk2 : mk3;
            const bool sel = ((mw >> (j & 31)) & 1u) != 0u;
            tile_body<0>(o, m, l, kf, qf, VSt + (size_t)j * 4096, KSt + (size_t)((jn >= 0) ? jn : j) * 4096, lane, j, s, s0, cur, sel, hi);
            j = jn;
        }
        l = xhalf_sum(l);
        const float sc = g1 / l;
#pragma unroll
        for (int r = 0; r < 16; ++r) { stash[r * 64] += o[0][r] * sc; stash[(16 + r) * 64] += o[1][r] * sc; }
    }
    f32x16 oacc[2];
    {
        float m = NEGV, l = 0.f; f32x16 o[2]; o[0] = z16; o[1] = z16;
        const int jhi = s0 >> 6; const int jlo = (s0 < 511) ? 0 : ((s0 - 511) >> 6);
        bf16x8 kf[8]; ld_frags(kf, KWt + (size_t)jhi * 4096, lane);
        for (int j = jhi; j >= jlo; --j)
            tile_body<1>(o, m, l, kf, qf, VWt + (size_t)j * 4096, KWt + (size_t)((j > jlo) ? j - 1 : j) * 4096, lane, j, s, s0, cur, true, hi);
        l = xhalf_sum(l);
        const float sc = g2 / l;
#pragma unroll
        for (int r = 0; r < 16; ++r) { oacc[0][r] = stash[r * 64] + o[0][r] * sc; oacc[1][r] = stash[(16 + r) * 64] + o[1][r] * sc; }
    }
    {
        float ss = 0.f;
#pragma unroll
        for (int r = 0; r < 16; ++r) ss += oacc[0][r] * oacc[0][r] + oacc[1][r] * oacc[1][r];
        ss = xhalf_sum(ss);
        const float rstd = 1.0f / sqrtf(ss * (1.0f / 64.0f) + EPS);
        const int cb = (g * 4 + hh) * 64;
#pragma unroll
        for (int d0 = 0; d0 < 2; ++d0)
#pragma unroll
            for (int rr = 0; rr < 4; ++rr) {
                const int d = 32 * d0 + 8 * rr + 4 * hi;
                const f32x4 gg = *(const f32x4*)(P.goa + cb + d);
                u32x2 w; w.x = pk2(oacc[d0][4 * rr] * rstd * gg.x, oacc[d0][4 * rr + 1] * rstd * gg.y); w.y = pk2(oacc[d0][4 * rr + 2] * rstd * gg.z, oacc[d0][4 * rr + 3] * rstd * gg.w);
                *(u32x2*)(Y + (size_t)tok * DM + 512 + cb + d) = w;
            }
    }
    WSYNC();
}
__device__ __forceinline__ void ph_attn(const Params& P, unsigned char* lds) {
    const int lane = threadIdx.x & 63, wave = __builtin_amdgcn_readfirstlane(threadIdx.x >> 6);
    const int gw = blockIdx.x * NWV + wave, NGW = gridDim.x * NWV;
    float* impA = (float*)(lds + wave * 8192); float* impB = impA + 1024;
    unsigned* qctr = (unsigned*)(P.ws + WS_BAR) + 4096;
    const int pref = (int)(xcc_id_hw() & 3u);
    for (int k = 0; k < 4; ++k) {
        const int bg = (pref + k) & 3;
        for (;;) {
            unsigned t = 0u;
            if (lane == 0) t = __hip_atomic_fetch_add(qctr + 64 * bg, 1u, __ATOMIC_RELAXED, __HIP_MEMORY_SCOPE_AGENT);
            t = (unsigned)__builtin_amdgcn_readfirstlane((int)t);
            if (t >= 1024u) break;
            attn_unit(P, impA, impB, bg, 1023 - (int)t, lane);
        }
    }
}

__device__ __forceinline__ void ph_compress(const Params& P, unsigned char* lds) {
    const int tid = threadIdx.x, lane = tid & 63, wave = __builtin_amdgcn_readfirstlane(tid >> 6), r32 = lane & 31, hi = lane >> 5;
    unsigned char* aspan = lds;
    bf16_t* hid = (bf16_t*)(lds + 67584);
    float* bias = (float*)(lds + 67584 + 32 * 264 * 2);
    const f32x16 z16 = {0.f, 0.f, 0.f, 0.f, 0.f, 0.f, 0.f, 0.f, 0.f, 0.f, 0.f, 0.f, 0.f, 0.f, 0.f, 0.f};
    for (int it = blockIdx.x; it < 128; it += gridDim.x) {
        const int X = it >> 6, bg = (it >> 4) & 3, ch = it & 15, i0 = ch * 32;
        const bf16_t* src = (const bf16_t*)(P.ws + WS_KV + (size_t)X * 4 * MiB) + (size_t)bg * SEQ * 64;
        const bf16_t* W1t = (const bf16_t*)(P.ws + (X ? WS_WC1V : WS_WC1K));
        const bf16_t* W2t = (const bf16_t*)(P.ws + (X ? WS_WC2V : WS_WC2K));
        const float* bpp = (const float*)(P.ws + WS_B1P) + X * 32 * 256;
        bf16_t* dst = (bf16_t*)(P.ws + (X ? WS_VCC : WS_KCC)) + (size_t)bg * 512 * 64;
        __syncthreads();
        {
            const bf16_t* PROJ = (const bf16_t*)(P.ws + WS_BIG);
            const int bb = bg >> 1, gg = bg & 1;
            u32x4 vraw[9];
#pragma unroll
            for (int r = 0; r < 9; ++r) { const int e = tid + 512 * r;
                const int tk = e >> 3, c = e & 7, st = 16 * i0 + tk; const bool ok = (e < 528 * 8) && (st < SEQ);
                vraw[r] = (u32x4){0u, 0u, 0u, 0u};
                if (ok) vraw[r] = *(const u32x4*)(PROJ + (size_t)(bb * SEQ + st) * PJ + C_KV + X * 128 + gg * 64 + c * 8); }
#pragma unroll
            for (int r = 0; r < 9; ++r) { const int e = tid + 512 * r;
                const int tk = e >> 3, c = e & 7, st = 16 * i0 + tk; const bool ok = (e < 528 * 8) && (st < SEQ);
                u32x4 v = vraw[r];
                u32x4 o; o.x = __shfl_xor(v.x, 1); o.y = __shfl_xor(v.y, 1); o.z = __shfl_xor(v.z, 1); o.w = __shfl_xor(v.w, 1);
                if (X == 0 && c < 2 && ok) {
                    float a[8], bq[8]; up8(v, a); up8(o, bq);
                    const float pf = (float)P.pos[bb * SEQ + st];
#pragma unroll
                    for (int q = 0; q < 8; ++q) {
                        constexpr float FRQ[8] = {1.0f, 0.1939227432012558f, 0.03760603070259094f, 0.007292664609849453f, 0.0014142135623842478f, 0.00027424818836152554f, 5.3182957344688475e-05f, 1.0313385246263351e-05f};
                        const float ang = pf * FRQ[q];
                        const double rev = (double)ang * 0.15915494309189535;
                        const float fx = (float)(rev - floor(rev));
                        const float cs = __builtin_amdgcn_cosf(fx), sn = __builtin_amdgcn_sinf(fx);
                        a[q] = (c == 0) ? (a[q] * cs - bq[q] * sn) : (a[q] * cs + bq[q] * sn);
                    }
                    v.x = pk2(a[0], a[1]); v.y = pk2(a[2], a[3]); v.z = pk2(a[4], a[5]); v.w = pk2(a[6], a[7]);
                }
                if (e < 528 * 8) *(u32x4*)(aspan + tk * 128 + ((c ^ ((tk >> 4) & 7)) << 4)) = v; }
        }
        if (tid < 256) { float v = 0.f;
#pragma unroll 8
            for (int ks = 0; ks < 32; ++ks) v += bpp[ks * 256 + tid];
            bias[tid] = v; }
        __syncthreads();
        f32x16 acc = z16;
        const bf16_t* bp1 = W1t + ((size_t)(wave * 128) * 64 + lane) * 8;
        bf16x8 wr[16];
#define CMP_LOAD16(dst, kb) do { } while (0)
#define CMP_MMA16(src, kb) do { } while (0)
#define CMP_FENCE() do { asm volatile("" ::: "memory"); __builtin_amdgcn_sched_barrier(0); } while (0)
#pragma unroll
        for (int q = 0; q < 16; ++q) wr[q] = *(const bf16x8*)(bp1 + (size_t)q * 512);
        CMP_FENCE();
#pragma unroll 1
        for (int kb = 0; kb < 8; ++kb) {
#pragma unroll
            for (int q = 0; q < 16; ++q) {
                const int ks = kb * 16 + q; const int tk = 16 * r32 + (ks >> 2), c = 2 * (ks & 3) + hi;
                const bf16x8 xa = *(const bf16x8*)(aspan + tk * 128 + ((c ^ ((tk >> 4) & 7)) << 4));
                acc = __builtin_amdgcn_mfma_f32_32x32x16_bf16(wr[q], xa, acc, 0, 0, 0);
                CMP_FENCE();
                wr[q] = *(const bf16x8*)(bp1 + (size_t)((kb < 7) ? ks + 16 : ks) * 512);
                CMP_FENCE();
            }
        }
#undef CMP_LOAD16
#undef CMP_MMA16
#undef CMP_FENCE
#pragma unroll
        for (int rr = 0; rr < 4; ++rr) {
            const int n0 = 32 * wave + 8 * rr + 4 * hi;
            const float v0 = silu_f(acc[4 * rr] + bias[n0]), v1 = silu_f(acc[4 * rr + 1] + bias[n0 + 1]), v2 = silu_f(acc[4 * rr + 2] + bias[n0 + 2]), v3 = silu_f(acc[4 * rr + 3] + bias[n0 + 3]);
            u32x2 w; w.x = cvtpk(v0, v1); w.y = cvtpk(v2, v3);
            *(u32x2*)(hid + r32 * 264 + n0) = w;
        }
        __syncthreads();
        if (wave < 2) {
            f32x16 c2 = z16;
#pragma unroll
            for (int ks = 0; ks < 16; ++ks) {
                const bf16x8 hf = *(const bf16x8*)(hid + r32 * 264 + ks * 16 + hi * 8);
                const bf16x8 wf = *(const bf16x8*)(W2t + (size_t)(32 * wave + r32) * 256 + ks * 16 + hi * 8);
                c2 = X ? __builtin_amdgcn_mfma_f32_32x32x16_bf16(hf, wf, c2, 0, 0, 0) : __builtin_amdgcn_mfma_f32_32x32x16_bf16(wf, hf, c2, 0, 0, 0);
            }
            if (!X) {
                const int kv = i0 + r32; const bool live = kv < 511;
#pragma unroll
                for (int rr = 0; rr < 4; ++rr) {
                    const int d0 = 32 * wave + 8 * rr + 4 * hi;
                    u32x2 w; w.x = cvtpk(c2[4 * rr], c2[4 * rr + 1]); w.y = cvtpk(c2[4 * rr + 2], c2[4 * rr + 3]);
                    if (!live) { w.x = 0u; w.y = 0u; }
                    *(u32x2*)(dst + ktile_off(kv, d0)) = w;
                }
            } else {
                if (i0 == 480 && hi == 1) c2[15] = 0.f;
                const int j = i0 >> 6;
#pragma unroll
                for (int ksl = 0; ksl < 2; ++ksl) {
                    u32x4 w; w.x = cvtpk(c2[8 * ksl], c2[8 * ksl + 1]); w.y = cvtpk(c2[8 * ksl + 2], c2[8 * ksl + 3]); w.z = cvtpk(c2[8 * ksl + 4], c2[8 * ksl + 5]); w.w = cvtpk(c2[8 * ksl + 6], c2[8 * ksl + 7]);
                    *(u32x4*)(dst + (size_t)j * 4096 + (((wave * 4 + 2 * (ch & 1) + ksl) * 64 + lane) << 3)) = w;
                }
            }
        }
        __syncthreads();
    }
}

#define GAS __attribute__((address_space(1)))
#define LAS __attribute__((address_space(3)))
#define XB_TMO      128
#define XB_XCNT(j)  (256  + 64 * (j))
#define XB_XSUB(j)  (1280 + 64 * (j))
#define XB_XGEN(j)  (2304 + 64 * (j))
#define XB_TOP      3328
#define XB_TOPGEN   3392
#define XCD_BAR_WORDS 3456
#define XB_SPIN_CAP (1u << 18)

__device__ __forceinline__ unsigned xb_ld(unsigned* p)              { return __hip_atomic_load(p, __ATOMIC_RELAXED, __HIP_MEMORY_SCOPE_AGENT); }
__device__ __forceinline__ unsigned xb_add(unsigned* p, unsigned v) { return __hip_atomic_fetch_add(p, v, __ATOMIC_RELAXED, __HIP_MEMORY_SCOPE_AGENT); }
__device__ __forceinline__ unsigned xb_xcc_id() { return (unsigned)__builtin_amdgcn_s_getreg((3 << 11) | 20) & 0xFu; }
#define XB_SPIN(cond, bar) do { unsigned _sp = 0; while (cond) { __builtin_amdgcn_s_sleep(1); \
    if ((++_sp & 255u) == 0u) { if (xb_ld(&(bar)[XB_TMO])) break; if (_sp > XB_SPIN_CAP) { atomicAdd(&(bar)[XB_TMO], 1u); break; } } } } while (0)

struct XcdBarrier {
    unsigned* bar; unsigned x;
    volatile LAS unsigned* st;
};

__device__ __forceinline__ XcdBarrier xcd_barrier_post(unsigned* bar, volatile LAS unsigned* st) {
    XcdBarrier b; b.bar = bar; b.x = xb_xcc_id(); b.st = st;
    if (threadIdx.x == 0) (void)xb_add(&bar[XB_XCNT(b.x)], 1u);
    return b;
}
__device__ __forceinline__ void xcd_barrier_complete(unsigned* bar, unsigned x, unsigned& nloc, unsigned& nx) {
    const unsigned G = gridDim.x * gridDim.y * gridDim.z;
    unsigned sum, cnt, mine, sp = 0u;
    for (;;) {
        sum = 0u; cnt = 0u; mine = 0u;
#pragma unroll
        for (unsigned j = 0; j < 16; ++j) { const unsigned c = xb_ld(&bar[XB_XCNT(j)]); sum += c; cnt += (c > 0u) ? 1u : 0u; mine = (j == x) ? c : mine; }
        if (sum == G) break;
        __builtin_amdgcn_s_sleep(1);
        if ((++sp & 255u) == 0u) { if (xb_ld(&bar[XB_TMO])) break; if (sp > XB_SPIN_CAP) { atomicAdd(&bar[XB_TMO], 1u); break; } }
    }
    nloc = mine > 0u ? mine : 1u; nx = cnt > 0u ? cnt : 1u;
}

__device__ __forceinline__ void xcd_barrier(const XcdBarrier& b) {
    asm volatile("s_waitcnt vmcnt(0)" ::: "memory");
    __syncthreads();
    if (threadIdx.x == 0) {
        unsigned* bar = b.bar;
        __builtin_amdgcn_s_waitcnt(0);
        unsigned nloc = b.st[0], nx = b.st[1];
        if (nloc == 0u) { xcd_barrier_complete(bar, b.x, nloc, nx); b.st[0] = nloc; b.st[1] = nx; }
        const unsigned old = xb_add(&bar[XB_XSUB(b.x)], 1u);
        const unsigned gen = old / nloc;
        if (old + 1u == (gen + 1u) * nloc) {
            __builtin_amdgcn_fence(__ATOMIC_RELEASE, "agent");
            asm volatile("s_waitcnt vmcnt(0)" ::: "memory");
            const unsigned og = xb_add(&bar[XB_TOP], 1u);
            const unsigned tg = og / nx;
            if (og + 1u == (tg + 1u) * nx) xb_add(&bar[XB_TOPGEN], 1u);
            else XB_SPIN(xb_ld(&bar[XB_TOPGEN]) == tg, bar);
            __builtin_amdgcn_fence(__ATOMIC_ACQUIRE, "agent");
            xb_add(&bar[XB_XGEN(b.x)], 1u);
            asm volatile("s_waitcnt vmcnt(0)" ::: "memory");
        } else {
            XB_SPIN(xb_ld(&bar[XB_XGEN(b.x)]) == gen, bar);
            __builtin_amdgcn_fence(__ATOMIC_ACQUIRE, "agent");
            asm volatile("s_waitcnt vmcnt(0)" ::: "memory");
        }
    }
    __syncthreads();
}

__global__ void __launch_bounds__(NTHR) mega(Params P, int lo, int hi) {
    extern __shared__ __attribute__((aligned(16))) unsigned char lds[];
    cg::grid_group grid = cg::this_grid();
#ifndef REPMASK
#define REPMASK 0
#endif
#ifndef PHMASK
#define PHMASK 0xFFFF
#endif
#define IN(k) ((((PHMASK) >> (k)) & 1) && lo <= (k) && (k) < hi)
#define REP(k) (((REPMASK) >> (k)) & 1)
    unsigned* barw = (unsigned*)(P.ws + WS_BAR);
    volatile LAS unsigned* MISC = (volatile LAS unsigned*)((LAS unsigned char*)lds + 131072 + 8192 + 256);
    if (threadIdx.x < 16) MISC[threadIdx.x] = 0u;
    __syncthreads();
    if (hi == -12345) grid.sync();
    XcdBarrier xbar = xcd_barrier_post(barw, MISC);
#define SEAM(k) xcd_barrier(xbar)
    bf16_t* XN = (bf16_t*)(P.ws + WS_XN); bf16_t* BIG = (bf16_t*)(P.ws + WS_BIG); bf16_t* Y = (bf16_t*)(P.ws + WS_Y);
    const float* MOD = (const float*)(P.ws + WS_MOD);
    __attribute__((address_space(3))) unsigned char* glds = (__attribute__((address_space(3))) unsigned char*)lds;
#ifdef XSYNC
#pragma nounroll
    for (int xs = 0; xs < XSYNC; ++xs) grid.sync();
#endif
    if (IN(0)) {
#pragma nounroll
        for (int rep = 0; rep < 1 + REP(0); ++rep) { if (rep) xcd_barrier(xbar); ph_mod_partial(P, lds); ph_weights(P, lds); }
    }
    SEAM(0);
    if (IN(1)) {
#pragma nounroll
        for (int rep = 0; rep < 1 + REP(1); ++rep) { if (rep) xcd_barrier(xbar); ph_norm(P, lds, P.x, P.g_ffn1, 0, true); }
    }
    SEAM(1);
    if (IN(2)) {
#pragma nounroll
        for (int rep = 0; rep < 1 + REP(2); ++rep) { if (rep) xcd_barrier(xbar);
        pg8::Gemm g{XN, (const bf16_t*)(P.ws + WS_W1GU), T, 2 * DFF, DM}; pg8::StaticOrder S; S.init(T, 2 * DFF, (int)gridDim.x, (int)blockIdx.x);
        pg8::EpiSwiglu E{BIG, DFF}; pg8::gemm_phase<pg8::EpiSwiglu, pg8::StaticOrder, true, true>(glds, g, S, E); }
    }
    SEAM(2);
    if (IN(3)) { pg8::Gemm g{BIG, (const bf16_t*)(P.ws + WS_W1D), T, DM, DFF}; pg8::StaticOrder S; S.init(T, DM, (int)gridDim.x, (int)blockIdx.x);
        pg8::EpiResidN E{P.x, P.out, MOD + 2 * DM, 0.5f, XN, P.g_mix, MOD + 4 * DM, (float*)(P.ws + WS_RSS)};
        pg8::gemm_phase<pg8::EpiResidN, pg8::StaticOrder, true, true>(glds, g, S, E);
        ph_bias_gemv(P, (const bf16_t*)(P.ws + WS_WIN), PJ, 3); }
    SEAM(3);
    if (IN(5)) { pg8::Gemm g{XN, (const bf16_t*)(P.ws + WS_WIN), T, PJ, DM}; pg8::StaticOrder S; S.init(T, PJ, (int)gridDim.x, (int)blockIdx.x);
        pg8::EpiBf16N E{BIG, PJ, (const float*)(P.ws + WS_RSS), (const float*)(P.ws + WS_BIAS), PJ}; pg8::gemm_phase<pg8::EpiBf16N, pg8::StaticOrder, true, true>(glds, g, S, E); }
    SEAM(5);
    if (IN(6)) { ph_compress(P, lds); ph_post(P, lds); }
    SEAM(6);
    if (IN(8)) {
#pragma nounroll
        for (int rep = 0; rep < 1 + REP(8); ++rep) { if (rep) xcd_barrier(xbar); ph_attn(P, lds); }
    }
    SEAM(8);
    if (IN(9)) { pg8::Gemm g{Y, (const bf16_t*)(P.ws + WS_WOUT), T, DM, DM}; pg8::StaticOrder S; S.init(T, DM, (int)gridDim.x, (int)blockIdx.x);
        pg8::EpiResidN E{P.out, P.out, MOD + 5 * DM, 1.0f, XN, P.g_ffn2, MOD + 7 * DM, (float*)(P.ws + WS_RSS)};
        pg8::gemm_phase<pg8::EpiResidN, pg8::StaticOrder, true, true>(glds, g, S, E);
        ph_bias_gemv(P, (const bf16_t*)(P.ws + WS_W2GU), 2 * DFF, 6); }
    SEAM(9);
    if (IN(11)) { pg8::Gemm g{XN, (const bf16_t*)(P.ws + WS_W2GU), T, 2 * DFF, DM}; pg8::StaticOrder S; S.init(T, 2 * DFF, (int)gridDim.x, (int)blockIdx.x);
        pg8::EpiSwigluN E{BIG, DFF, (const float*)(P.ws + WS_RSS), (const float*)(P.ws + WS_BIAS), 2 * DFF}; pg8::gemm_phase<pg8::EpiSwigluN, pg8::StaticOrder, true, true>(glds, g, S, E); }
    SEAM(11);
    if (IN(12)) { pg8::Gemm g{BIG, (const bf16_t*)(P.ws + WS_W2D), T, DM, DFF}; pg8::StaticOrder S; S.init(T, DM, (int)gridDim.x, (int)blockIdx.x);
        pg8::EpiResid E{P.out, P.out, MOD + 8 * DM, 0.5f}; pg8::gemm_phase<pg8::EpiResid, pg8::StaticOrder, true, true>(glds, g, S, E); }
    SEAM(12);
    if (IN(13)) ph_final_norm(P);
}
constexpr int NPHASE = 14;

extern "C" void kernel_launch(void* const* d_in, const int* in_sizes, int n_in, void* d_out, int out_size, void* d_ws, size_t ws_size, hipStream_t stream) {
    static int grid = 0;
    if (grid == 0) {
        int dev = 0, cus = 0, per_cu = 0;
        hipGetDevice(&dev);
        hipDeviceGetAttribute(&cus, hipDeviceAttributeMultiprocessorCount, dev);
        hipFuncSetAttribute((const void*)mega, hipFuncAttributeMaxDynamicSharedMemorySize, LDS_BYTES);
        hipOccupancyMaxActiveBlocksPerMultiprocessor(&per_cu, (const void*)mega, NTHR, LDS_BYTES);
        if (per_cu < 1) { fprintf(stderr, "kernel_launch: occupancy query reports %d blocks per CU\n", per_cu); per_cu = 1; }
        grid = cus * per_cu;
        (void)hipGetLastError();
    }
    (void)hipMemsetAsync((unsigned char*)d_ws + WS_BAR, 0, 4096 * 4 + 2048, stream);
    Params p{};
    const void** pp = (const void**)&p;
    for (int i = 0; i < 26; ++i) pp[i] = d_in[i];
    p.out = (float*)d_out; p.ws = (unsigned char*)d_ws;
    int lo = 0, hi = NPHASE;
    void* args[] = {&p, &lo, &hi};
    hipError_t e = hipLaunchCooperativeKernel((const void*)mega, dim3(grid), dim3(NTHR), args, LDS_BYTES, stream);
    if (e != hipSuccess) fprintf(stderr, "cooperative launch failed: %s (grid %d)\n", hipGetErrorString(e), grid);
}
```
